# Optimizing an MI355X kernel written in HIP

```python
import jax, jax.numpy as jnp
from jax import lax
import numpy as np

D_MODEL = 1024
BATCH = 2
SEQ = 8192
DEPTH = 2

CTX_LEN = 256
GRID_W = 64
N_POOL_GROUPS = 4
POOL_GROUP = 128
POOL_WIDTH = N_POOL_GROUPS * POOL_GROUP
POOL_WINDOWS = (2, 4, 8, 16)
GLA_HEADS = 4
GLA_DK = 64
GLA_DV = 128
GLA_KW = GLA_HEADS * GLA_DK
GLA_VW = GLA_HEADS * GLA_DV
GATE_RANK = 16
GATE_TAU = 16.0
CHUNK = 64
D_FF = 2816
N_MOD = 9
EPS = 1e-6

OFF_K = 0
OFF_V = OFF_K + GLA_KW
OFF_AF = OFF_V + GLA_VW
OFF_AB = OFF_AF + GATE_RANK
OFF_Q = OFF_AB + GATE_RANK
OFF_R = OFF_Q + GLA_KW
OFF_POOL = OFF_R + GLA_VW
OFF_GP = OFF_POOL + POOL_WIDTH
OFF_GG = OFF_GP + D_MODEL
IN_COLS = OFF_GG + D_MODEL

kernel_name = "hybrid_pool_gla_macaron_dit"


def rmsnorm(x, w):
    xf = x.astype(jnp.float32)
    y = xf * lax.rsqrt(jnp.mean(xf * xf, axis=-1, keepdims=True) + EPS)
    return (y * w.astype(jnp.float32)).astype(x.dtype)


def modulate(x, w, shift, scale):
    return rmsnorm(x, w) * (1 + scale) + shift


def modulation(cond, w_mod, b_mod):
    m = jax.nn.silu(cond) @ w_mod + b_mod
    return jnp.split(m, N_MOD, axis=-1)


def swiglu(h, w_up, w_down):
    a, b = jnp.split(h @ w_up, 2, axis=-1)
    return (jax.nn.silu(a) * b) @ w_down


def box_mean(u, w, axis):
    n = u.shape[axis]
    cs = jnp.cumsum(u.astype(jnp.float32), axis=axis)
    pad = [(0, 0)] * u.ndim
    pad[axis] = (1, 0)
    cs = jnp.pad(cs, pad)
    t = jnp.arange(n)
    lo = jnp.clip(t - w // 2, 0, n)
    hi = jnp.clip(t + w // 2, 0, n)
    s = jnp.take(cs, hi, axis=axis) - jnp.take(cs, lo, axis=axis)
    shape = [1] * u.ndim
    shape[axis] = n
    cnt = (hi - lo).astype(jnp.float32).reshape(shape)
    return (s / cnt).astype(u.dtype)


def pool_mix(u, grid, pool_w, pool_scale):
    B, L, _ = u.shape
    outs = []
    for gi, w in enumerate(POOL_WINDOWS):
        ug = u[..., gi * POOL_GROUP:(gi + 1) * POOL_GROUP]
        if grid:
            rows = L // GRID_W
            ugr = ug.reshape(B, rows, GRID_W, POOL_GROUP)
            m = box_mean(box_mean(ugr, w, 1), w, 2).reshape(B, L, POOL_GROUP)
        else:
            m = box_mean(ug, w, 1)
        outs.append(m - ug)
    p = jnp.stack(outs, axis=2)
    y = jnp.einsum('blgp,gpq->blgq', p, pool_w).reshape(B, L, POOL_WIDTH)
    return y * pool_scale


def to_heads(t, d):
    B, L, _ = t.shape
    return t.reshape(B, L, GLA_HEADS, d).transpose(0, 2, 1, 3)


def log_forget(a_low, w_up, b):
    return jax.nn.log_sigmoid((a_low @ w_up + b).astype(jnp.float32)) / GATE_TAU


def gla_kvg(proj, lp):
    k = to_heads(proj[..., OFF_K:OFF_V], GLA_DK)
    v = to_heads(proj[..., OFF_V:OFF_AF], GLA_DV)
    g_f = to_heads(log_forget(proj[..., OFF_AF:OFF_AB], lp['w_af_up'], lp['b_af']), GLA_DK)
    g_b = to_heads(log_forget(proj[..., OFF_AB:OFF_Q], lp['w_ab_up'], lp['b_ab']), GLA_DK)
    return k, v, g_f, g_b


def flip_seq(t):
    return jnp.flip(t, axis=2)


def gla_chunked(q, k, v, g, s0, inclusive):
    f32 = jnp.float32
    B, H, L, dk = q.shape
    dv = v.shape[-1]
    n = L // CHUNK
    qc = q.astype(f32).reshape(B, H, n, CHUNK, dk)
    kc = k.astype(f32).reshape(B, H, n, CHUNK, dk)
    vc = v.astype(f32).reshape(B, H, n, CHUNK, dv)
    b = jnp.cumsum(g.astype(f32).reshape(B, H, n, CHUNK, dk), axis=3)
    b_last = b[:, :, :, -1:, :]
    q_t = qc * jnp.exp(b)
    k_t = kc * jnp.exp(-b)
    k_end = kc * jnp.exp(b_last - b)
    mask = jnp.tril(jnp.ones((CHUNK, CHUNK), bool), 0 if inclusive else -1)
    att = jnp.where(mask, jnp.einsum('bhncd,bhnmd->bhncm', q_t, k_t), 0.0)
    o = jnp.einsum('bhncm,bhnme->bhnce', att, vc)
    kv = jnp.einsum('bhncd,bhnce->bhnde', k_end, vc)
    decay = jnp.exp(b_last[:, :, :, 0, :])

    def step(s, inp):
        kv_n, dec_n = inp
        return s * dec_n[..., None] + kv_n, s

    _, s_prev = lax.scan(step, s0.astype(f32), (jnp.moveaxis(kv, 2, 0), jnp.moveaxis(decay, 2, 0)))
    s_prev = jnp.moveaxis(s_prev, 0, 2)
    o = o + jnp.einsum('bhncd,bhnde->bhnce', q_t, s_prev)
    return o.reshape(B, H, L, dv).astype(v.dtype)


def gla_final_state(k, v, g):
    f32 = jnp.float32
    b = jnp.cumsum(g.astype(f32), axis=2)
    dec = jnp.exp(b[:, :, -1:, :] - b)
    return jnp.einsum('bhld,bhle->bhde', k.astype(f32) * dec, v.astype(f32))


def context_states(proj, lp):
    k, v, g_f, g_b = gla_kvg(proj, lp)
    s_f = gla_final_state(k, v, g_f)
    s_b = gla_final_state(flip_seq(k), flip_seq(v), flip_seq(g_b))
    return s_f, s_b


def gla_branch(proj, s_f0, s_b0, lp):
    k, v, g_f, g_b = gla_kvg(proj, lp)
    q = to_heads(proj[..., OFF_Q:OFF_R], GLA_DK) * (GLA_DK ** -0.5)
    o_f = gla_chunked(q, k, v, g_f, s_f0, True)
    o_b = flip_seq(gla_chunked(flip_seq(q), flip_seq(k), flip_seq(v), flip_seq(g_b), s_b0, False))
    o = rmsnorm(o_f + o_b, lp['gla_norm_w'])
    B, H, L, _ = o.shape
    o = o.transpose(0, 2, 1, 3).reshape(B, L, GLA_VW)
    return o * jax.nn.silu(proj[..., OFF_R:OFF_POOL])


def token_mixer(h, grid, s_f0, s_b0, lp):
    proj = h @ lp['w_in']
    y_gla = gla_branch(proj, s_f0, s_b0, lp) @ lp['w_br_gla']
    y_pool = pool_mix(proj[..., OFF_POOL:OFF_GP], grid, lp['pool_w'], lp['pool_scale']) @ lp['w_br_pool']
    merged = jax.nn.sigmoid(proj[..., OFF_GP:OFF_GG]) * y_pool + jax.nn.sigmoid(proj[..., OFF_GG:IN_COLS]) * y_gla
    return merged @ lp['w_out'], proj


def setup_inputs(seed: int = 0) -> dict:
    key = jax.random.key(seed)
    ks = jax.random.split(key, 24)
    f32 = jnp.float32
    L = DEPTH

    def nrm(k, shape, fan):
        return jax.random.normal(k, shape, f32) * (fan ** -0.5)

    def near_one(k, shape):
        return 1.0 + 0.02 * jax.random.normal(k, shape, f32)

    def small(k, shape, s):
        return s * jax.random.normal(k, shape, f32)

    return {
        "x": jax.random.normal(ks[0], (BATCH, SEQ, D_MODEL), f32),
        "c": jax.random.normal(ks[1], (BATCH, D_MODEL), f32),
        "ctx": jax.random.normal(ks[2], (BATCH, CTX_LEN, D_MODEL), f32),
        "c_ctx": jax.random.normal(ks[3], (D_MODEL,), f32),
        "w_mod": nrm(ks[4], (L, D_MODEL, N_MOD * D_MODEL), D_MODEL),
        "b_mod": small(ks[5], (L, N_MOD * D_MODEL), 0.02),
        "norm_w": near_one(ks[6], (L, 3, D_MODEL)),
        "ffn1_up": nrm(ks[7], (L, D_MODEL, 2 * D_FF), D_MODEL),
        "ffn1_down": nrm(ks[8], (L, D_FF, D_MODEL), D_FF),
        "w_in": nrm(ks[9], (L, D_MODEL, IN_COLS), D_MODEL),
        "w_af_up": nrm(ks[10], (L, GATE_RANK, GLA_KW), GATE_RANK),
        "b_af": small(ks[11], (L, GLA_KW), 0.1),
        "w_ab_up": nrm(ks[12], (L, GATE_RANK, GLA_KW), GATE_RANK),
        "b_ab": small(ks[13], (L, GLA_KW), 0.1),
        "gla_norm_w": near_one(ks[14], (L, GLA_DV)),
        "pool_w": nrm(ks[15], (L, N_POOL_GROUPS, POOL_GROUP, POOL_GROUP), POOL_GROUP),
        "pool_scale": near_one(ks[16], (L, POOL_WIDTH)),
        "w_br_pool": nrm(ks[17], (L, POOL_WIDTH, D_MODEL), POOL_WIDTH),
        "w_br_gla": nrm(ks[18], (L, GLA_VW, D_MODEL), GLA_VW),
        "w_out": nrm(ks[19], (L, D_MODEL, D_MODEL), D_MODEL),
        "ffn2_up": nrm(ks[20], (L, D_MODEL, 2 * D_FF), D_MODEL),
        "ffn2_down": nrm(ks[21], (L, D_FF, D_MODEL), D_FF),
        "final_norm_w": near_one(ks[22], (D_MODEL,)),
    }


def reference(x, c, ctx, c_ctx, w_mod, b_mod, norm_w, ffn1_up, ffn1_down, w_in, w_af_up, b_af,
              w_ab_up, b_ab, gla_norm_w, pool_w, pool_scale, w_br_pool, w_br_gla, w_out,
              ffn2_up, ffn2_down, final_norm_w):
    B = x.shape[0]
    zero_state = jnp.zeros((B, GLA_HEADS, GLA_DK, GLA_DV), jnp.float32)
    for l in range(DEPTH):
        last = l == DEPTH - 1
        lp = {
            'w_in': w_in[l], 'w_af_up': w_af_up[l], 'b_af': b_af[l], 'w_ab_up': w_ab_up[l],
            'b_ab': b_ab[l], 'gla_norm_w': gla_norm_w[l], 'pool_w': pool_w[l],
            'pool_scale': pool_scale[l], 'w_br_pool': w_br_pool[l], 'w_br_gla': w_br_gla[l],
            'w_out': w_out[l],
        }
        nw = norm_w[l]
        sh1, sc1, g1, sh2, sc2, g2, sh3, sc3, g3 = modulation(c[:, None, :], w_mod[l], b_mod[l])
        ch1, cs1, cg1, ch2, cs2, cg2, ch3, cs3, cg3 = modulation(c_ctx[None, None, :], w_mod[l], b_mod[l])

        x = x + 0.5 * g1 * swiglu(modulate(x, nw[0], sh1, sc1), ffn1_up[l], ffn1_down[l])
        ctx = ctx + 0.5 * cg1 * swiglu(modulate(ctx, nw[0], ch1, cs1), ffn1_up[l], ffn1_down[l])

        hc = modulate(ctx, nw[1], ch2, cs2)
        if last:
            s_f, s_b = context_states(hc @ w_in[l][:, :OFF_Q], lp)
        else:
            yc, projc = token_mixer(hc, False, zero_state, zero_state, lp)
            s_f, s_b = context_states(projc, lp)
            ctx = ctx + cg2 * yc
            ctx = ctx + 0.5 * cg3 * swiglu(modulate(ctx, nw[2], ch3, cs3), ffn2_up[l], ffn2_down[l])

        yx, _ = token_mixer(modulate(x, nw[1], sh2, sc2), True, s_f, s_b, lp)
        x = x + g2 * yx

        x = x + 0.5 * g3 * swiglu(modulate(x, nw[2], sh3, sc3), ffn2_up[l], ffn2_down[l])
    return rmsnorm(x, final_norm_w)
```

```cpp
#include <hip/hip_runtime.h>
#include <hip/hip_cooperative_groups.h>
#include <cstdio>
namespace cg = cooperative_groups;
namespace pg8 {
#define PG8_LAS __attribute__((address_space(3)))
typedef unsigned short bf16_t;
typedef short bf16x8 __attribute__((ext_vector_type(8)));
typedef float f32x4 __attribute__((ext_vector_type(4)));
typedef unsigned u32x4 __attribute__((ext_vector_type(4)));
constexpr int BM = 256, BK = 64, HALF = 128, HTB = HALF * BK * 2  , STAGE_BYTES = 8 * HTB, NXCD = 8, WGM = 8;

__host__ __device__ __forceinline__ int lds_byte(int r, int c) { const int st = (r >> 4) * 2 + (c >> 5), rr = r & 15, cc = c & 31, ob = rr * 64 + cc * 2; return st * 1024 + (ob ^ (((ob >> 9) & 1) << 5)); }
__host__ __device__ __forceinline__ void stage_rc(int b, int& R, int& C) { const int st = b / 1024, sb = b % 1024, swz = sb ^ (((sb >> 9) & 1) << 5); R = (st >> 1) * 16 + swz / 64; C = (st & 1) * 32 + (swz % 64) / 2; }
__host__ __device__ __forceinline__ int perm32(int rho) { const int n = rho >> 4, i = rho & 15; return 8 * (i >> 2) + 4 * n + (i & 3); }

struct Unit { int pm, pn; };
struct Gemm { const bf16_t* A; const bf16_t* Bt; int M, N, K; };

struct StaticOrder {
    int nM, nN, nwg, G, c;
    __host__ __device__ void init(int M, int N, int G_, int c_) { nM = M / BM; nN = N / BM; nwg = nM * nN; G = G_; c = c_; }
    __host__ __device__ bool next(int i, Unit& u) const {
        const long L = (long)i * G + c; if (L >= nwg) return false;
        int wgid = (int)L; { const int q = nwg / NXCD, r = nwg % NXCD, xcd = wgid % NXCD, off = wgid / NXCD; wgid = (xcd < r ? xcd * (q + 1) : r * (q + 1) + (xcd - r) * q) + off; }
        const int nig = WGM * nN, gid = wgid / nig, fm = gid * WGM, gsz = (nM - fm) < WGM ? (nM - fm) : WGM;
        u.pm = fm + ((wgid % nig) % gsz); u.pn = (wgid % nig) / gsz; return true;
    }
    __device__ __forceinline__ void a_ready(const Unit&) const {}
    __device__ __forceinline__ void done(const Unit&) const {}
};
__device__ __forceinline__ unsigned cvt_pk_bf16(float lo, float hi) { unsigned r; asm volatile("v_cvt_pk_bf16_f32 %0, %1, %2" : "=v"(r) : "v"(lo), "v"(hi)); return r; }
typedef float f32x2 __attribute__((ext_vector_type(2)));

template <class Epi, class Sched, bool STAMP = false>
__device__ __forceinline__ void gemm_phase(PG8_LAS unsigned char* lds, const Gemm g, const Sched& S, const Epi& E, unsigned long long* stamps) {
    const int tid = threadIdx.x, wid = __builtin_amdgcn_readfirstlane(tid >> 6), lane = tid & 63, wr = wid >> 2, wc = wid & 3, fr = lane & 15, fq = lane >> 4;
    const int K = g.K, nt = K / BK;
    int ts_lo = 0, ts_hi = 0, nts = 0; const unsigned long long rt_entry = STAMP ? (unsigned long long)wall_clock64() : 0ull;
#define PG8_STAMP() do { if (STAMP && wid == 0 && nts < 64) { const unsigned long long _c = (unsigned long long)clock64(); \
        ts_lo = (lane == nts) ? (int)(unsigned)_c : ts_lo; ts_hi = (lane == nts) ? (int)(unsigned)(_c >> 32) : ts_hi; ++nts; } } while (0)
    PG8_STAMP();
    unsigned voffA[2], voffB[2];
#pragma unroll
    for (int i = 0; i < 2; ++i) { int R, C; stage_rc(tid * 16 + i * 8192, R, C); const int Rb = Epi::PERM ? ((R & ~31) + perm32(R & 31)) : R;
        voffA[i] = (unsigned)(R * K + C) * 2u; voffB[i] = (unsigned)(Rb * K + C) * 2u; }
    const size_t kstep = (size_t)(BK * 2);
    const size_t hstep = (size_t)HALF * K * 2;
    const size_t tstep = 2 * hstep;
    const unsigned ldsw = (unsigned)wid * 1024u;
    const int aoff = lds_byte(wr * 64 + fr, fq * 8), boff = lds_byte(wc * 32 + fr, fq * 8);
#define PG8_SA(b, h) (((b) * 2 + (h)) * HTB)
#define PG8_SB(b, h) ((4 + (b) * 2 + (h)) * HTB)
#define PG8_STAGE(bufoff, gbase, voff) do { _Pragma("unroll") for (int _i = 0; _i < 2; ++_i) \
        __builtin_amdgcn_global_load_lds((const unsigned*)((const char*)(gbase) + (voff)[_i]), (PG8_LAS unsigned*)(lds + (bufoff) + ldsw + _i * 8192), 16, 0, 0); } while (0)
#define PG8_LDA(dst, b, h) do { _Pragma("unroll") for (int m = 0; m < 4; ++m) _Pragma("unroll") for (int k = 0; k < 2; ++k) dst[m][k] = *(const PG8_LAS bf16x8*)(lds + PG8_SA(b, h) + aoff + m * 2048 + k * 1024); } while (0)
#define PG8_LDB(dst, b, h) do { _Pragma("unroll") for (int n = 0; n < 2; ++n) _Pragma("unroll") for (int k = 0; k < 2; ++k) dst[n][k] = *(const PG8_LAS bf16x8*)(lds + PG8_SB(b, h) + boff + n * 2048 + k * 1024); } while (0)
#define PG8_MMA(ai, bj, At, Bt) do { __builtin_amdgcn_s_setprio(1); _Pragma("unroll") for (int m = 0; m < 4; ++m) _Pragma("unroll") for (int n = 0; n < 2; ++n) _Pragma("unroll") for (int k = 0; k < 2; ++k) \
        acc[ai][bj][m][n] = __builtin_amdgcn_mfma_f32_16x16x32_bf16(Bt[n][k], At[m][k], acc[ai][bj][m][n], 0, 0, 0); __builtin_amdgcn_s_setprio(0); } while (0)
#define PG8_WAIT_V(n) asm volatile("s_waitcnt vmcnt(" #n ")" ::: "memory")
#define PG8_WAIT_L(n) asm volatile("s_waitcnt lgkmcnt(" #n ")" ::: "memory")
#define PG8_BAR __builtin_amdgcn_s_barrier()
#define PG8_SCHED __builtin_amdgcn_sched_barrier(0)
    Unit cur, nxt; int ui = 0;
    if (!S.next(0, cur)) return;
    f32x4 acc[2][2][4][2];
#pragma unroll
    for (int a = 0; a < 2; ++a)
#pragma unroll
        for (int b = 0; b < 2; ++b)
#pragma unroll
            for (int m = 0; m < 4; ++m)
#pragma unroll
                for (int n = 0; n < 2; ++n) acc[a][b][m][n] = (f32x4){0.f, 0.f, 0.f, 0.f};
    bf16x8 At[4][2], B0[2][2], B1[2][2];
    const char* cA = (const char*)g.A + (size_t)cur.pm * tstep; const char* cB = (const char*)g.Bt + (size_t)cur.pn * tstep;
    S.a_ready(cur);
    PG8_STAGE(PG8_SB(0, 0), cB, voffB); PG8_STAGE(PG8_SA(0, 0), cA, voffA); PG8_STAGE(PG8_SB(0, 1), cB + hstep, voffB); PG8_STAGE(PG8_SA(0, 1), cA + hstep, voffA);
    if (wr == 1) PG8_BAR;
    PG8_WAIT_V(4); PG8_BAR;
    PG8_STAGE(PG8_SB(1, 0), cB + kstep, voffB); PG8_STAGE(PG8_SA(1, 0), cA + kstep, voffA); PG8_STAGE(PG8_SB(1, 1), cB + hstep + kstep, voffB);
    PG8_WAIT_V(6); PG8_BAR;
    PG8_STAMP();
    for (;;) {
        const bool has_next = S.next(ui + 1, nxt);
        const char* nA = has_next ? (const char*)g.A + (size_t)nxt.pm * tstep : cA; const char* nB = has_next ? (const char*)g.Bt + (size_t)nxt.pn * tstep : cB;
        for (int t = 0; t < nt; t += 2) {
            const bool last = (t == nt - 2);
            const char* a1 = cA + (size_t)(t + 1) * kstep;
            const char* a2 = last ? nA : cA + (size_t)(t + 2) * kstep; const char* b2 = last ? nB : cB + (size_t)(t + 2) * kstep;
            const char* a3 = a2 + kstep; const char* b3 = b2 + kstep;
            if (last && has_next) S.a_ready(nxt);
            PG8_LDB(B0, 0, 0); PG8_SCHED; PG8_LDA(At, 0, 0); PG8_STAGE(PG8_SA(1, 1), a1 + hstep, voffA);
            PG8_WAIT_L(8); PG8_BAR; PG8_WAIT_L(0); PG8_MMA(0, 0, At, B0); PG8_BAR; PG8_SCHED;
            PG8_LDB(B1, 0, 1); PG8_STAGE(PG8_SB(0, 0), b2, voffB);
            PG8_BAR; PG8_WAIT_L(0); PG8_MMA(0, 1, At, B1); PG8_BAR;
            PG8_LDA(At, 0, 1); PG8_STAGE(PG8_SA(0, 0), a2, voffA);
            PG8_BAR; PG8_WAIT_L(0); PG8_MMA(1, 0, At, B0); PG8_BAR; PG8_SCHED;
            PG8_STAGE(PG8_SB(0, 1), b2 + hstep, voffB);
            PG8_WAIT_V(6); PG8_BAR; PG8_MMA(1, 1, At, B1); PG8_BAR;
            PG8_LDB(B0, 1, 0); PG8_SCHED; PG8_LDA(At, 1, 0); PG8_STAGE(PG8_SA(0, 1), a2 + hstep, voffA);
            PG8_WAIT_L(8); PG8_BAR; PG8_WAIT_L(0); PG8_MMA(0, 0, At, B0); PG8_BAR; PG8_SCHED;
            PG8_LDB(B1, 1, 1); PG8_STAGE(PG8_SB(1, 0), b3, voffB);
            PG8_BAR; PG8_WAIT_L(0); PG8_MMA(0, 1, At, B1); PG8_BAR;
            PG8_LDA(At, 1, 1); PG8_STAGE(PG8_SA(1, 0), a3, voffA);
            PG8_BAR; PG8_WAIT_L(0); PG8_MMA(1, 0, At, B0); PG8_BAR; PG8_SCHED;
            PG8_STAGE(PG8_SB(1, 1), b3 + hstep, voffB);
            PG8_WAIT_V(6); PG8_BAR; PG8_MMA(1, 1, At, B1); PG8_BAR;
        }
        PG8_STAMP();
        if constexpr (!Epi::AFTER_DRAIN) { E(acc, cur, wr, wc, fr, fq); S.done(cur); }
        PG8_STAMP();
        if (!has_next) break;
#pragma unroll
        for (int a = 0; a < 2; ++a)
#pragma unroll
            for (int b = 0; b < 2; ++b)
#pragma unroll
                for (int m = 0; m < 4; ++m)
#pragma unroll
                    for (int n = 0; n < 2; ++n) acc[a][b][m][n] = (f32x4){0.f, 0.f, 0.f, 0.f};
        cur = nxt; cA = nA; cB = nB; ++ui;
    }
    PG8_WAIT_V(0);
    if (wr == 0) PG8_BAR;
    PG8_BAR;
    if constexpr (Epi::AFTER_DRAIN) { E.fused(acc, cur, wr, wc, fr, fq, lds, wid, lane); S.done(cur); }
    PG8_STAMP();
    if (STAMP && wid == 0) { stamps[lane] = lane < nts ? (((unsigned long long)(unsigned)ts_hi << 32) | (unsigned)ts_lo) : 0ull;
        if (lane == 62) stamps[62] = rt_entry; if (lane == 63) stamps[63] = (unsigned long long)wall_clock64(); }
#undef PG8_STAMP
#undef PG8_SA
#undef PG8_SB
#undef PG8_STAGE
#undef PG8_LDA
#undef PG8_LDB
#undef PG8_MMA
#undef PG8_WAIT_V
#undef PG8_WAIT_L
#undef PG8_BAR
#undef PG8_SCHED
}
}

#define LAS __attribute__((address_space(3)))
typedef unsigned short bf16_t;
typedef short bf16x8 __attribute__((ext_vector_type(8)));
typedef float f32x4 __attribute__((ext_vector_type(4)));
typedef unsigned u32x4 __attribute__((ext_vector_type(4)));
typedef unsigned u32x2 __attribute__((ext_vector_type(2)));

constexpr int D = 1024, SEQ = 8192, NB = 2, CTXL = 256, DFF = 2816, DEPTH = 2;
constexpr int RL = NB * SEQ;
constexpr int RC = NB * CTXL;
constexpr int R = RL + RC;
constexpr int INC = 4128;
constexpr int OFF_K = 0, OFF_V = 256, OFF_AF = 768, OFF_Q = 800, OFF_R = 1056, OFF_POOL = 1568, OFF_GP = 2080, OFF_GG = 3104;
constexpr int PA_K = 0, PA_V = 256, PA_Q = 768, PA_R = 1024, PA_P = 1536, PAW = 2048;
constexpr int NCHUNK = R / 64;
constexpr int NITEM = NCHUNK * 4 * 2;
constexpr int NMOD = 9 * D;

constexpr size_t WL_UP1 = 0, WL_DN1 = 11534336, WL_WIN = 17301504, WL_LRT = 25690112, WL_WPT = 25755648, WL_WGT = 26804224,
                 WL_WOT = 27852800, WL_UP2 = 29949952, WL_DN2 = 41484288, WL_SIZE = 47251456;
constexpr size_t WS_W = 0;
constexpr size_t WS_H = WS_W + 2 * WL_SIZE;
constexpr size_t WS_PA = WS_H + (size_t)R * 1024 * 2;
constexpr size_t WS_PG = WS_PA + (size_t)R * 2048 * 2;
constexpr size_t WS_KV = WS_PG + (size_t)R * 2048 * 2;
constexpr size_t WS_P = WS_KV + (size_t)NITEM * 8192 * 2;
constexpr size_t WS_LR = WS_P + (size_t)R * 512 * 2;
constexpr size_t WS_CX = WS_LR + (size_t)R * 32 * 4;
constexpr size_t WS_MOD = WS_CX + (size_t)RC * 1024 * 4;
constexpr size_t WS_DEC = WS_MOD + (size_t)DEPTH * 3 * NMOD * 4;
constexpr size_t WS_END = WS_DEC + (size_t)NITEM * 64 * 4;
constexpr int LDS_BYTES = 147456;

struct Params {
    const float *x, *c, *ctx, *c_ctx, *w_mod, *b_mod, *norm_w, *ffn1_up, *ffn1_down, *w_in, *w_af_up, *b_af, *w_ab_up, *b_ab,
                *gla_norm_w, *pool_w, *pool_scale, *w_br_pool, *w_br_gla, *w_out, *ffn2_up, *ffn2_down, *final_norm_w;
    float* out; unsigned char* ws;
};

__device__ __forceinline__ unsigned f2bf(float f) { unsigned u = __builtin_bit_cast(unsigned, f); return (u + 0x7fffu + ((u >> 16) & 1u)) >> 16; }
__device__ __forceinline__ unsigned pk2(float lo, float hi) { return f2bf(lo) | (f2bf(hi) << 16); }
__device__ __forceinline__ float bf2f(unsigned short b) { return __builtin_bit_cast(float, ((unsigned)b) << 16); }
__device__ __forceinline__ float bflo(unsigned w) { return __builtin_bit_cast(float, w << 16); }
__device__ __forceinline__ float bfhi(unsigned w) { return __builtin_bit_cast(float, w & 0xffff0000u); }
__device__ __forceinline__ float sigmoidf_(float v) { return 1.f / (1.f + __expf(-v)); }
__device__ __forceinline__ float siluf_(float v) { return v / (1.f + __expf(-v)); }
__device__ __forceinline__ float log_sigmoidf_(float v) { return fminf(v, 0.f) - log1pf(__expf(-fabsf(v))); }
__device__ __forceinline__ float wave_sum(float v) {
#pragma unroll
    for (int o = 1; o < 64; o <<= 1) v += __shfl_xor(v, o);
    return v;
}
__device__ __forceinline__ int mod_index(int r) { return r < SEQ ? 0 : (r < RL ? 1 : 2); }
__device__ __forceinline__ float* xrow_ptr(float* xl, float* xc, int r) { return r < RL ? xl + (size_t)r * D : xc + (size_t)(r - RL) * D; }

struct EpiSwiGLU {
    static constexpr bool PERM = true, AFTER_DRAIN = false;
    bf16_t* O;
    __device__ __forceinline__ void operator()(const f32x4 (&acc)[2][2][4][2], const pg8::Unit& u, int wr, int wc, int fr, int fq) const {
        const int row0 = u.pm * 256 + wr * 64 + fr, col0 = u.pn * 128 + wc * 16 + 4 * fq;
#pragma unroll
        for (int ai = 0; ai < 2; ++ai)
#pragma unroll
            for (int m = 0; m < 4; ++m) { bf16_t* rowp = O + (size_t)(row0 + ai * 128 + m * 16) * DFF + col0;
#pragma unroll
                for (int bj = 0; bj < 2; ++bj) { const f32x4 a = acc[ai][bj][m][0], b = acc[ai][bj][m][1];
                    u32x2 w; w.x = pk2(siluf_(a[0]) * b[0], siluf_(a[1]) * b[1]); w.y = pk2(siluf_(a[2]) * b[2], siluf_(a[3]) * b[3]);
                    *(u32x2*)(rowp + bj * 64) = w; } }
    }
};
struct EpiResid {
    static constexpr bool PERM = false, AFTER_DRAIN = false;
    float* xl; float* xc; const float* gate; float coef;
    __device__ __forceinline__ void operator()(const f32x4 (&acc)[2][2][4][2], const pg8::Unit& u, int wr, int wc, int fr, int fq) const {
        const int row0 = u.pm * 256 + wr * 64 + fr, col0 = u.pn * 256 + wc * 32 + 4 * fq;
#pragma unroll
        for (int ai = 0; ai < 2; ++ai)
#pragma unroll
            for (int m = 0; m < 4; ++m) { const int r = row0 + ai * 128 + m * 16; float* rowp = xrow_ptr(xl, xc, r) + col0; const float* gp = gate + (size_t)mod_index(r) * NMOD + col0;
#pragma unroll
                for (int bj = 0; bj < 2; ++bj)
#pragma unroll
                    for (int n = 0; n < 2; ++n) { const int off = bj * 128 + n * 16; const f32x4 g = *(const f32x4*)(gp + off); f32x4 xv = *(const f32x4*)(rowp + off);
                        xv = xv + (g * coef) * acc[ai][bj][m][n]; *(f32x4*)(rowp + off) = xv; } }
    }
};
struct EpiProj {
    static constexpr bool PERM = true, AFTER_DRAIN = false;
    bf16_t* O0; bf16_t* O1;
    __device__ __forceinline__ void operator()(const f32x4 (&acc)[2][2][4][2], const pg8::Unit& u, int wr, int wc, int fr, int fq) const {
        const int row0 = u.pm * 256 + wr * 64 + fr; int colt = u.pn * 256; bf16_t* base = O0; if (colt >= 2048) { base = O1; colt -= 2048; }
        const int col0 = colt + wc * 32 + 8 * fq;
#pragma unroll
        for (int ai = 0; ai < 2; ++ai)
#pragma unroll
            for (int m = 0; m < 4; ++m) { bf16_t* rowp = base + (size_t)(row0 + ai * 128 + m * 16) * PAW + col0;
#pragma unroll
                for (int bj = 0; bj < 2; ++bj) { const f32x4 v0 = acc[ai][bj][m][0], v1 = acc[ai][bj][m][1];
                    u32x4 w; w.x = pk2(v0[0], v0[1]); w.y = pk2(v0[2], v0[3]); w.z = pk2(v1[0], v1[1]); w.w = pk2(v1[2], v1[3]);
                    *(u32x4*)(rowp + bj * 128) = w; } }
    }
};
struct EpiBranch {
    static constexpr bool PERM = true, AFTER_DRAIN = false;
    bf16_t* MG; const bf16_t* PG; int goff; int accum;
    __device__ __forceinline__ void operator()(const f32x4 (&acc)[2][2][4][2], const pg8::Unit& u, int wr, int wc, int fr, int fq) const {
        const int row0 = u.pm * 256 + wr * 64 + fr, col0 = u.pn * 256 + wc * 32 + 8 * fq;
#pragma unroll
        for (int ai = 0; ai < 2; ++ai)
#pragma unroll
            for (int m = 0; m < 4; ++m) { const int r = row0 + ai * 128 + m * 16; bf16_t* rowp = MG + (size_t)r * 1024 + col0; const bf16_t* gp = PG + (size_t)r * PAW + goff + col0;
#pragma unroll
                for (int bj = 0; bj < 2; ++bj) { const f32x4 v0 = acc[ai][bj][m][0], v1 = acc[ai][bj][m][1];
                    const u32x4 g = *(const u32x4*)(gp + bj * 128);
                    float o[8];
                    o[0] = sigmoidf_(bflo(g.x)) * v0[0]; o[1] = sigmoidf_(bfhi(g.x)) * v0[1]; o[2] = sigmoidf_(bflo(g.y)) * v0[2]; o[3] = sigmoidf_(bfhi(g.y)) * v0[3];
                    o[4] = sigmoidf_(bflo(g.z)) * v1[0]; o[5] = sigmoidf_(bfhi(g.z)) * v1[1]; o[6] = sigmoidf_(bflo(g.w)) * v1[2]; o[7] = sigmoidf_(bfhi(g.w)) * v1[3];
                    if (accum) { const u32x4 old = *(const u32x4*)(rowp + bj * 128);
                        o[0] += bflo(old.x); o[1] += bfhi(old.x); o[2] += bflo(old.y); o[3] += bfhi(old.y); o[4] += bflo(old.z); o[5] += bfhi(old.z); o[6] += bflo(old.w); o[7] += bfhi(old.w); }
                    u32x4 w; w.x = pk2(o[0], o[1]); w.y = pk2(o[2], o[3]); w.z = pk2(o[4], o[5]); w.w = pk2(o[6], o[7]);
                    *(u32x4*)(rowp + bj * 128) = w; } }
    }
};

template <class Epi>
__device__ __forceinline__ void run_gemm(LAS unsigned char* lds, const bf16_t* A, const bf16_t* Bt, int N, int K, const Epi& E) {
    pg8::Gemm g{A, Bt, R, N, K}; pg8::StaticOrder S; S.init(R, N, (int)gridDim.x, (int)blockIdx.x);
    pg8::gemm_phase<Epi, pg8::StaticOrder, false>(lds, g, S, E, nullptr);
}

__device__ __forceinline__ int src_col(int kind, int n, float& sc) {
    sc = 1.f;
    if (kind == 0) return n;
    if (kind == 1) { const int q = n >> 3, e = n & 7; return e < 4 ? 4 * q + e : DFF + 4 * q + (e - 4); }
    if (kind == 2) { if (n < 256) return OFF_K + n; if (n < 768) return OFF_V + (n - 256); if (n < 1024) { sc = 0.125f; return OFF_Q + (n - 768); }
        if (n < 1536) return OFF_R + (n - 1024); if (n < 2048) return OFF_POOL + (n - 1536); if (n < 3072) return OFF_GP + (n - 2048); return OFF_GG + (n - 3072); }
    return OFF_AF + n;
}
__device__ __forceinline__ void tconv_job(const float* __restrict__ src, int ld, int K, int N, bf16_t* dst, int kind, LAS float* tile, int& base) {
    const int tid = threadIdx.x, G = gridDim.x;
    const int nnb = (N + 63) / 64, nt = (K / 64) * nnb;
    const int first = (((int)blockIdx.x - base) % G + G) % G;
    for (int t = first; t < nt; t += G) {
        const int k0 = (t / nnb) * 64, n0 = (t % nnb) * 64;
        { const int j = tid & 63, i0 = tid >> 6; float sc = 1.f; const bool ok = (n0 + j) < N; const int col = ok ? src_col(kind, n0 + j, sc) : 0;
#pragma unroll
          for (int i = 0; i < 8; ++i) { const int kk = i0 + 8 * i; tile[kk * 65 + j] = ok ? src[(size_t)(k0 + kk) * ld + col] * sc : 0.f; } }
        __syncthreads();
        { const int n = tid >> 3, ch = tid & 7; const LAS float* s = tile + (8 * ch) * 65 + n;
          if (n0 + n < N) { u32x4 o; o.x = pk2(s[0], s[65]); o.y = pk2(s[130], s[195]); o.z = pk2(s[260], s[325]); o.w = pk2(s[390], s[455]);
              *(u32x4*)(dst + (size_t)(n0 + n) * K + k0 + 8 * ch) = o; } }
        __syncthreads();
    }
    base += nt;
}

__device__ __forceinline__ void phase0(const Params& p, LAS unsigned char* lds) {
    const int tid = threadIdx.x, lane = tid & 63, wave = tid >> 6, G = gridDim.x;
    LAS float* tile = (LAS float*)lds;
    LAS float* scond = (LAS float*)(lds + 20480);
    LAS float* red = (LAS float*)(lds + 20480 + 12288);
    unsigned char* ws = p.ws;
    int base = 0;
    for (int l = 0; l < DEPTH; ++l) {
        unsigned char* wl = ws + WS_W + (size_t)l * WL_SIZE;
        tconv_job(p.ffn1_up + (size_t)l * D * 2 * DFF, 2 * DFF, D, 2 * DFF, (bf16_t*)(wl + WL_UP1), 1, tile, base);
        tconv_job(p.ffn1_down + (size_t)l * DFF * D, D, DFF, D, (bf16_t*)(wl + WL_DN1), 0, tile, base);
        tconv_job(p.w_in + (size_t)l * D * INC, INC, D, 4096, (bf16_t*)(wl + WL_WIN), 2, tile, base);
        tconv_job(p.w_in + (size_t)l * D * INC, INC, D, 32, (bf16_t*)(wl + WL_LRT), 3, tile, base);
        tconv_job(p.w_br_gla + (size_t)l * 512 * D, D, 512, D, (bf16_t*)(wl + WL_WGT), 0, tile, base);
        tconv_job(p.w_out + (size_t)l * D * D, D, D, D, (bf16_t*)(wl + WL_WOT), 0, tile, base);
        tconv_job(p.ffn2_up + (size_t)l * D * 2 * DFF, 2 * DFF, D, 2 * DFF, (bf16_t*)(wl + WL_UP2), 1, tile, base);
        tconv_job(p.ffn2_down + (size_t)l * DFF * D, D, DFF, D, (bf16_t*)(wl + WL_DN2), 0, tile, base);
    }
    const int gt = (int)blockIdx.x * 512 + tid, NT = G * 512;
    for (int idx = gt; idx < DEPTH * 512 * 256; idx += NT) {
        const int n4 = idx & 255, k = (idx >> 8) & 511, l = idx >> 17, g = k >> 7, kl = k & 127;
        const float* pw = p.pool_w + ((size_t)(l * 4 + g) * 128 + kl) * 128; const float* ps = p.pool_scale + l * 512 + g * 128;
        const float* wb = p.w_br_pool + ((size_t)l * 512 + g * 128) * D + n4 * 4;
        f32x4 a = {0.f, 0.f, 0.f, 0.f};
#pragma unroll 4
        for (int j = 0; j < 128; ++j) { const float s = pw[j] * ps[j]; a = a + *(const f32x4*)(wb + (size_t)j * D) * s; }
        bf16_t* d = (bf16_t*)(ws + WS_W + (size_t)l * WL_SIZE + WL_WPT) + (size_t)(n4 * 4) * 512 + k;
        d[0] = (bf16_t)f2bf(a[0]); d[512] = (bf16_t)f2bf(a[1]); d[1024] = (bf16_t)f2bf(a[2]); d[1536] = (bf16_t)f2bf(a[3]);
    }
    for (int i = tid; i < 3 * D; i += 512) { const int mi = i >> 10, kk = i & 1023; const float v = mi < 2 ? p.c[mi * D + kk] : p.c_ctx[kk]; scond[i] = siluf_(v); }
    __syncthreads();
    float* MOD = (float*)(ws + WS_MOD);
    for (int it = G - 1 - (int)blockIdx.x; it < DEPTH * 144; it += G) {
        const int l = it / 144, n0 = (it % 144) * 64; const float* wm = p.w_mod + (size_t)l * D * NMOD + n0 + lane;
        float a0 = 0.f, a1 = 0.f, a2 = 0.f;
#pragma unroll 8
        for (int kk = wave; kk < D; kk += 8) { const float w = wm[(size_t)kk * NMOD]; a0 += scond[kk] * w; a1 += scond[D + kk] * w; a2 += scond[2 * D + kk] * w; }
        red[(wave * 3 + 0) * 64 + lane] = a0; red[(wave * 3 + 1) * 64 + lane] = a1; red[(wave * 3 + 2) * 64 + lane] = a2;
        __syncthreads();
        if (tid < 192) { const int mi = tid >> 6, j = tid & 63; float s = p.b_mod[l * NMOD + n0 + j];
#pragma unroll
            for (int w = 0; w < 8; ++w) s += red[(w * 3 + mi) * 64 + j];
            MOD[(size_t)(l * 3 + mi) * NMOD + n0 + j] = s; }
        __syncthreads();
    }
    { const f32x4* s = (const f32x4*)p.x; f32x4* d = (f32x4*)p.out; for (int i = gt; i < RL * D / 4; i += NT) d[i] = s[i]; }
    { const f32x4* s = (const f32x4*)p.ctx; f32x4* d = (f32x4*)(ws + WS_CX); for (int i = gt; i < RC * D / 4; i += NT) d[i] = s[i]; }
}

__device__ __forceinline__ void norm_phase(const Params& p, int l, int which) {
    const int tid = threadIdx.x, lane = tid & 63, wave = tid >> 6;
    const int gw = (int)blockIdx.x * 8 + wave, NGW = (int)gridDim.x * 8;
    const float* nw = p.norm_w + (size_t)(l * 3 + which) * D;
    const float* MOD = (const float*)(p.ws + WS_MOD) + (size_t)l * 3 * NMOD;
    float* xc = (float*)(p.ws + WS_CX); bf16_t* H = (bf16_t*)(p.ws + WS_H);
    for (int r = gw; r < R; r += NGW) {
        const f32x4* xr = (const f32x4*)xrow_ptr(p.out, xc, r) + lane;
        const float* mrow = MOD + (size_t)mod_index(r) * NMOD + (3 * which) * D;
        f32x4 v[4]; float s = 0.f;
#pragma unroll
        for (int j = 0; j < 4; ++j) { v[j] = xr[64 * j]; s += (v[j][0] * v[j][0] + v[j][1] * v[j][1]) + (v[j][2] * v[j][2] + v[j][3] * v[j][3]); }
        const float rstd = rsqrtf(wave_sum(s) * (1.f / D) + 1e-6f);
        u32x2* o8 = (u32x2*)(H + (size_t)r * D) + lane;
#pragma unroll
        for (int j = 0; j < 4; ++j) { const int c = 256 * j + 4 * lane;
            const f32x4 w = *(const f32x4*)(nw + c), sh = *(const f32x4*)(mrow + c), sc = *(const f32x4*)(mrow + D + c);
            const f32x4 h = (v[j] * rstd) * w * (sc + 1.f) + sh;
            u32x2 o; o.x = pk2(h[0], h[1]); o.y = pk2(h[2], h[3]); o8[64 * j] = o; }
    }
}
__device__ __forceinline__ void final_norm(const Params& p) {
    const int tid = threadIdx.x, lane = tid & 63, wave = tid >> 6;
    const int gw = (int)blockIdx.x * 8 + wave, NGW = (int)gridDim.x * 8;
    for (int r = gw; r < RL; r += NGW) {
        f32x4* xr = (f32x4*)(p.out + (size_t)r * D) + lane;
        f32x4 v[4]; float s = 0.f;
#pragma unroll
        for (int j = 0; j < 4; ++j) { v[j] = xr[64 * j]; s += (v[j][0] * v[j][0] + v[j][1] * v[j][1]) + (v[j][2] * v[j][2] + v[j][3] * v[j][3]); }
        const float rstd = rsqrtf(wave_sum(s) * (1.f / D) + 1e-6f);
#pragma unroll
        for (int j = 0; j < 4; ++j) { const f32x4 w = *(const f32x4*)(p.final_norm_w + 256 * j + 4 * lane); xr[64 * j] = (v[j] * rstd) * w; }
    }
}

__device__ __forceinline__ void lowrank_phase(const Params& p, int l) {
    const int tid = threadIdx.x, lane = tid & 63, wave = tid >> 6, fr = lane & 15, fq = lane >> 4;
    const int gw = (int)blockIdx.x * 8 + wave, NGW = (int)gridDim.x * 8;
    const bf16_t* H = (const bf16_t*)(p.ws + WS_H); const bf16_t* lrt = (const bf16_t*)(p.ws + WS_W + (size_t)l * WL_SIZE + WL_LRT);
    float* LR = (float*)(p.ws + WS_LR);
    for (int it = gw; it < R / 16; it += NGW) {
        const int r0 = it * 16;
        const bf16_t* ap = H + (size_t)(r0 + fr) * D + fq * 8; const bf16_t* bp = lrt + (size_t)fr * D + fq * 8;
        f32x4 acc0 = {0.f, 0.f, 0.f, 0.f}, acc1 = {0.f, 0.f, 0.f, 0.f};
#pragma unroll 4
        for (int ks = 0; ks < 32; ++ks) { const bf16x8 a = *(const bf16x8*)(ap + ks * 32), b0 = *(const bf16x8*)(bp + ks * 32), b1 = *(const bf16x8*)(bp + 16 * D + ks * 32);
            acc0 = __builtin_amdgcn_mfma_f32_16x16x32_bf16(a, b0, acc0, 0, 0, 0); acc1 = __builtin_amdgcn_mfma_f32_16x16x32_bf16(a, b1, acc1, 0, 0, 0); }
#pragma unroll
        for (int j = 0; j < 4; ++j) { float* o = LR + (size_t)(r0 + fq * 4 + j) * 32 + fr; o[0] = acc0[j]; o[16] = acc1[j]; }
    }
}

__device__ __forceinline__ void gla_gates(const Params& p, int l, int r0, int h, LAS float* Bf, LAS float* Bb) {
    const int tid = threadIdx.x, dk = tid & 63, cgp = tid >> 6;
    const float* LR = (const float*)(p.ws + WS_LR);
    const float* wf = p.w_af_up + (size_t)l * 16 * 256 + h * 64 + dk; const float* wb = p.w_ab_up + (size_t)l * 16 * 256 + h * 64 + dk;
    float wfr[16], wbr[16];
#pragma unroll
    for (int i = 0; i < 16; ++i) { wfr[i] = wf[i * 256]; wbr[i] = wb[i * 256]; }
    const float bfv = p.b_af[l * 256 + h * 64 + dk], bbv = p.b_ab[l * 256 + h * 64 + dk];
#pragma unroll 2
    for (int cc = 0; cc < 8; ++cc) { const int c = cgp * 8 + cc; const float* lr = LR + (size_t)(r0 + c) * 32;
        float af = bfv, ab = bbv;
#pragma unroll
        for (int i = 0; i < 16; ++i) { af += lr[i] * wfr[i]; ab += lr[16 + i] * wbr[i]; }
        Bf[c * 64 + dk] = log_sigmoidf_(af) * (1.f / 16.f); Bb[c * 64 + dk] = log_sigmoidf_(ab) * (1.f / 16.f); }
    __syncthreads();
    if (tid < 64) { float run = 0.f; for (int c = 0; c < 64; ++c) { run += Bf[c * 64 + tid]; Bf[c * 64 + tid] = run; } }
    else if (tid < 128) { const int d2 = tid - 64; float run = 0.f; for (int c = 63; c >= 0; --c) { run += Bb[c * 64 + d2]; Bb[c * 64 + d2] = run; } }
    __syncthreads();
}
constexpr int LP = 72;

__device__ __forceinline__ void gla_kv_phase(const Params& p, int l, LAS unsigned char* lds) {
    const int tid = threadIdx.x, lane = tid & 63, wave = tid >> 6, fr = lane & 15, fq = lane >> 4, G = gridDim.x;
    LAS float* Bf = (LAS float*)lds; LAS float* Bb = (LAS float*)(lds + 16384);
    LAS bf16_t* keT0 = (LAS bf16_t*)(lds + 32768); LAS bf16_t* keT1 = (LAS bf16_t*)(lds + 32768 + 9216); LAS bf16_t* vT = (LAS bf16_t*)(lds + 32768 + 18432);
    const bf16_t* PA = (const bf16_t*)(p.ws + WS_PA); bf16_t* KV = (bf16_t*)(p.ws + WS_KV); float* DEC = (float*)(p.ws + WS_DEC);
    for (int it = blockIdx.x; it < NCHUNK * 4; it += G) {
        const int cgi = it >> 2, h = it & 3, r0 = cgi * 64;
        gla_gates(p, l, r0, h, Bf, Bb);
        { const int c = tid >> 3, sub = tid & 7; const bf16_t* rowp = PA + (size_t)(r0 + c) * PAW;
          const bf16x8 kk = *(const bf16x8*)(rowp + PA_K + h * 64 + sub * 8);
#pragma unroll
          for (int i = 0; i < 8; ++i) { const int dk = sub * 8 + i; const float kf = bf2f((unsigned short)kk[i]);
              keT0[dk * LP + c] = (bf16_t)f2bf(kf * __expf(Bf[63 * 64 + dk] - Bf[c * 64 + dk]));
              keT1[dk * LP + c] = (bf16_t)f2bf(kf * __expf(Bb[dk] - Bb[c * 64 + dk])); }
          const bf16x8 v0 = *(const bf16x8*)(rowp + PA_V + h * 128 + sub * 16), v1 = *(const bf16x8*)(rowp + PA_V + h * 128 + sub * 16 + 8);
#pragma unroll
          for (int i = 0; i < 8; ++i) { vT[(sub * 16 + i) * LP + c] = (bf16_t)v0[i]; vT[(sub * 16 + 8 + i) * LP + c] = (bf16_t)v1[i]; } }
        if (tid < 128) { const int d = tid >> 6, dk = tid & 63; DEC[(size_t)(it * 2 + d) * 64 + dk] = __expf(d == 0 ? Bf[63 * 64 + dk] : Bb[dk]); }
        __syncthreads();
        { const int e0 = wave * 16;
          bf16x8 bv[2];
#pragma unroll
          for (int ks = 0; ks < 2; ++ks) bv[ks] = *(const LAS bf16x8*)(vT + (e0 + fr) * LP + ks * 32 + fq * 8);
#pragma unroll
          for (int d = 0; d < 2; ++d) { const LAS bf16_t* ke = d == 0 ? keT0 : keT1; bf16_t* dst = KV + (size_t)(it * 2 + d) * 8192 + (size_t)(e0 + fr) * 64;
#pragma unroll
              for (int dt = 0; dt < 4; ++dt) { f32x4 acc = {0.f, 0.f, 0.f, 0.f};
#pragma unroll
                  for (int ks = 0; ks < 2; ++ks) { const bf16x8 a = *(const LAS bf16x8*)(ke + (dt * 16 + fr) * LP + ks * 32 + fq * 8); acc = __builtin_amdgcn_mfma_f32_16x16x32_bf16(a, bv[ks], acc, 0, 0, 0); }
                  u32x2 w; w.x = pk2(acc[0], acc[1]); w.y = pk2(acc[2], acc[3]); *(u32x2*)(dst + dt * 16 + fq * 4) = w; } } }
        __syncthreads();
    }
    bf16_t* P = (bf16_t*)(p.ws + WS_P);
    LAS float* cs = (LAS float*)lds; constexpr int CSP = 132;
    for (int it = blockIdx.x; it < NB * 128 * 4; it += G) {
        const int gi = it & 3, Rr = (it >> 2) & 127, b = it >> 9, half = 1 << gi;
        const int rlo = max(Rr - half, 0), rhi = min(Rr + half, 128);
        const int col = tid >> 3, ch0 = (tid & 7) * 16;
        const bf16_t* basep = PA + (size_t)(b * SEQ) * PAW + PA_P + gi * 128 + ch0;
        float acc[16], uc[16];
#pragma unroll
        for (int i = 0; i < 16; ++i) { acc[i] = 0.f; uc[i] = 0.f; }
        for (int rr = rlo; rr < rhi; ++rr) { const bf16_t* pp = basep + (size_t)(rr * 64 + col) * PAW; const bf16x8 a0 = *(const bf16x8*)pp, a1 = *(const bf16x8*)(pp + 8);
            const bool ctr = (rr == Rr);
#pragma unroll
            for (int i = 0; i < 8; ++i) { const float f0 = bf2f((unsigned short)a0[i]), f1 = bf2f((unsigned short)a1[i]); acc[i] += f0; acc[8 + i] += f1; if (ctr) { uc[i] = f0; uc[8 + i] = f1; } } }
#pragma unroll
        for (int i = 0; i < 16; ++i) cs[col * CSP + ch0 + i] = acc[i];
        __syncthreads();
        const int clo = max(col - half, 0), chi = min(col + half, 64);
        float sum[16];
#pragma unroll
        for (int i = 0; i < 16; ++i) sum[i] = 0.f;
        for (int cc = clo; cc < chi; ++cc) {
#pragma unroll
            for (int i = 0; i < 16; ++i) sum[i] += cs[cc * CSP + ch0 + i]; }
        const float inv = 1.f / (float)((rhi - rlo) * (chi - clo));
        bf16_t* op = P + (size_t)(b * SEQ + Rr * 64 + col) * 512 + gi * 128 + ch0;
        u32x4 w0, w1;
        w0.x = pk2(sum[0] * inv - uc[0], sum[1] * inv - uc[1]); w0.y = pk2(sum[2] * inv - uc[2], sum[3] * inv - uc[3]);
        w0.z = pk2(sum[4] * inv - uc[4], sum[5] * inv - uc[5]); w0.w = pk2(sum[6] * inv - uc[6], sum[7] * inv - uc[7]);
        w1.x = pk2(sum[8] * inv - uc[8], sum[9] * inv - uc[9]); w1.y = pk2(sum[10] * inv - uc[10], sum[11] * inv - uc[11]);
        w1.z = pk2(sum[12] * inv - uc[12], sum[13] * inv - uc[13]); w1.w = pk2(sum[14] * inv - uc[14], sum[15] * inv - uc[15]);
        *(u32x4*)op = w0; *(u32x4*)(op + 8) = w1;
        __syncthreads();
    }
    for (int idx = (int)blockIdx.x * 512 + tid; idx < RC * 32; idx += G * 512) {
        const int tok = idx >> 5, ch0 = (idx & 31) * 16, gi = ch0 >> 7, half = 1 << gi, b = tok >> 8, t = tok & 255;
        const int lo = max(t - half, 0), hi = min(t + half, CTXL);
        const bf16_t* basep = PA + (size_t)(RL + b * CTXL) * PAW + PA_P + ch0;
        float acc[16], uc[16];
#pragma unroll
        for (int i = 0; i < 16; ++i) { acc[i] = 0.f; uc[i] = 0.f; }
        for (int tt = lo; tt < hi; ++tt) { const bf16_t* pp = basep + (size_t)tt * PAW; const bf16x8 a0 = *(const bf16x8*)pp, a1 = *(const bf16x8*)(pp + 8);
            const bool ctr = (tt == t);
#pragma unroll
            for (int i = 0; i < 8; ++i) { const float f0 = bf2f((unsigned short)a0[i]), f1 = bf2f((unsigned short)a1[i]); acc[i] += f0; acc[8 + i] += f1; if (ctr) { uc[i] = f0; uc[8 + i] = f1; } } }
        const float inv = 1.f / (float)(hi - lo);
        bf16_t* op = P + (size_t)(RL + tok) * 512 + ch0;
        u32x4 w0, w1;
        w0.x = pk2(acc[0] * inv - uc[0], acc[1] * inv - uc[1]); w0.y = pk2(acc[2] * inv - uc[2], acc[3] * inv - uc[3]);
        w0.z = pk2(acc[4] * inv - uc[4], acc[5] * inv - uc[5]); w0.w = pk2(acc[6] * inv - uc[6], acc[7] * inv - uc[7]);
        w1.x = pk2(acc[8] * inv - uc[8], acc[9] * inv - uc[9]); w1.y = pk2(acc[10] * inv - uc[10], acc[11] * inv - uc[11]);
        w1.z = pk2(acc[12] * inv - uc[12], acc[13] * inv - uc[13]); w1.w = pk2(acc[14] * inv - uc[14], acc[15] * inv - uc[15]);
        *(u32x4*)op = w0; *(u32x4*)(op + 8) = w1;
    }
}

__device__ __forceinline__ int scan_item(int step, int b, int h, int d) {
    int cgi;
    if (step < 4) cgi = 256 + b * 4 + (d == 0 ? step : 3 - step);
    else cgi = b * 128 + (d == 0 ? step - 4 : 127 - (step - 4));
    return (cgi * 4 + h) * 2 + d;
}
__device__ __forceinline__ void gla_scan_phase(const Params& p) {
    bf16_t* KV = (bf16_t*)(p.ws + WS_KV); const float* DEC = (const float*)(p.ws + WS_DEC);
    for (int idx = (int)blockIdx.x * 512 + (int)threadIdx.x; idx < 16 * 8192; idx += (int)gridDim.x * 512) {
        const int sid = idx >> 13, el = idx & 8191, dk = el & 63, d = sid & 1, h = (sid >> 1) & 3, b = sid >> 3;
        float s = 0.f;
        { float kv[4], dc[4]; int item[4];
#pragma unroll
          for (int i = 0; i < 4; ++i) { item[i] = scan_item(i, b, h, d); kv[i] = bf2f(KV[(size_t)item[i] * 8192 + el]); dc[i] = DEC[(size_t)item[i] * 64 + dk]; }
#pragma unroll
          for (int i = 0; i < 4; ++i) { KV[(size_t)item[i] * 8192 + el] = (bf16_t)f2bf(s); s = s * dc[i] + kv[i]; } }
        for (int s0 = 4; s0 < 132; s0 += 8) { float kv[8], dc[8]; int item[8];
#pragma unroll
          for (int i = 0; i < 8; ++i) { item[i] = scan_item(s0 + i, b, h, d); kv[i] = bf2f(KV[(size_t)item[i] * 8192 + el]); dc[i] = DEC[(size_t)item[i] * 64 + dk]; }
#pragma unroll
          for (int i = 0; i < 8; ++i) { KV[(size_t)item[i] * 8192 + el] = (bf16_t)f2bf(s); s = s * dc[i] + kv[i]; } }
    }
}

__device__ __forceinline__ void gla_out_phase(const Params& p, int l, LAS unsigned char* lds) {
    const int tid = threadIdx.x, lane = tid & 63, wave = tid >> 6, fr = lane & 15, fq = lane >> 4, G = gridDim.x;
    LAS float* Bf = (LAS float*)lds; LAS float* Bb = (LAS float*)(lds + 16384);
    LAS bf16_t* qt0 = (LAS bf16_t*)(lds + 32768); LAS bf16_t* qt1 = (LAS bf16_t*)(lds + 32768 + 9216);
    LAS bf16_t* kt0 = (LAS bf16_t*)(lds + 32768 + 2 * 9216); LAS bf16_t* kt1 = (LAS bf16_t*)(lds + 32768 + 3 * 9216);
    LAS bf16_t* vT = (LAS bf16_t*)(lds + 32768 + 4 * 9216);
    LAS bf16_t* attw = (LAS bf16_t*)(lds + 32768 + 4 * 9216 + 18432) + wave * (16 * LP);
    LAS float* red = (LAS float*)(lds + 32768 + 4 * 9216 + 18432 + 8 * 16 * LP * 2);
    const bf16_t* PA = (const bf16_t*)(p.ws + WS_PA); const bf16_t* KV = (const bf16_t*)(p.ws + WS_KV); bf16_t* GO = (bf16_t*)(p.ws + WS_H);
    const float* gnw = p.gla_norm_w + l * 128;
    const int ct = wave & 3, eh = wave >> 2;
    for (int it = blockIdx.x; it < NCHUNK * 4; it += G) {
        const int cgi = it >> 2, h = it & 3, r0 = cgi * 64;
        gla_gates(p, l, r0, h, Bf, Bb);
        { const int c = tid >> 3, sub = tid & 7; const bf16_t* rowp = PA + (size_t)(r0 + c) * PAW;
          const bf16x8 qq = *(const bf16x8*)(rowp + PA_Q + h * 64 + sub * 8), kk = *(const bf16x8*)(rowp + PA_K + h * 64 + sub * 8);
          float qf[8], kf[8], qb[8], kb[8];
#pragma unroll
          for (int i = 0; i < 8; ++i) { const int dk = sub * 8 + i; const float q = bf2f((unsigned short)qq[i]), k = bf2f((unsigned short)kk[i]); const float bf = Bf[c * 64 + dk], bb = Bb[c * 64 + dk];
              qf[i] = q * __expf(bf); kf[i] = k * __expf(-bf); qb[i] = q * __expf(bb); kb[i] = k * __expf(-bb); }
          u32x4 w;
          w.x = pk2(qf[0], qf[1]); w.y = pk2(qf[2], qf[3]); w.z = pk2(qf[4], qf[5]); w.w = pk2(qf[6], qf[7]); *(LAS u32x4*)(qt0 + c * LP + sub * 8) = w;
          w.x = pk2(qb[0], qb[1]); w.y = pk2(qb[2], qb[3]); w.z = pk2(qb[4], qb[5]); w.w = pk2(qb[6], qb[7]); *(LAS u32x4*)(qt1 + c * LP + sub * 8) = w;
          w.x = pk2(kf[0], kf[1]); w.y = pk2(kf[2], kf[3]); w.z = pk2(kf[4], kf[5]); w.w = pk2(kf[6], kf[7]); *(LAS u32x4*)(kt0 + c * LP + sub * 8) = w;
          w.x = pk2(kb[0], kb[1]); w.y = pk2(kb[2], kb[3]); w.z = pk2(kb[4], kb[5]); w.w = pk2(kb[6], kb[7]); *(LAS u32x4*)(kt1 + c * LP + sub * 8) = w;
          const bf16x8 v0 = *(const bf16x8*)(rowp + PA_V + h * 128 + sub * 16), v1 = *(const bf16x8*)(rowp + PA_V + h * 128 + sub * 16 + 8);
#pragma unroll
          for (int i = 0; i < 8; ++i) { vT[(sub * 16 + i) * LP + c] = (bf16_t)v0[i]; vT[(sub * 16 + 8 + i) * LP + c] = (bf16_t)v1[i]; } }
        __syncthreads();
        f32x4 acco[4];
#pragma unroll
        for (int et = 0; et < 4; ++et) acco[et] = (f32x4){0.f, 0.f, 0.f, 0.f};
#pragma unroll
        for (int d = 0; d < 2; ++d) {
            const LAS bf16_t* qt = d == 0 ? qt0 : qt1; const LAS bf16_t* kt = d == 0 ? kt0 : kt1;
            bf16x8 aq[2];
#pragma unroll
            for (int ks = 0; ks < 2; ++ks) aq[ks] = *(const LAS bf16x8*)(qt + (ct * 16 + fr) * LP + ks * 32 + fq * 8);
#pragma unroll
            for (int mt = 0; mt < 4; ++mt) { f32x4 s = {0.f, 0.f, 0.f, 0.f};
#pragma unroll
                for (int ks = 0; ks < 2; ++ks) { const bf16x8 bk = *(const LAS bf16x8*)(kt + (mt * 16 + fr) * LP + ks * 32 + fq * 8); s = __builtin_amdgcn_mfma_f32_16x16x32_bf16(aq[ks], bk, s, 0, 0, 0); }
                const int mm = mt * 16 + fr;
#pragma unroll
                for (int j = 0; j < 4; ++j) { const int cc = ct * 16 + fq * 4 + j; const bool keep = d == 0 ? (mm <= cc) : (mm > cc);
                    attw[(fq * 4 + j) * LP + mm] = (bf16_t)f2bf(keep ? s[j] : 0.f); } }
            __syncthreads();
            bf16x8 aa[2];
#pragma unroll
            for (int ks = 0; ks < 2; ++ks) aa[ks] = *(const LAS bf16x8*)(attw + fr * LP + ks * 32 + fq * 8);
            const bf16_t* sT = KV + (size_t)(it * 2 + d) * 8192;
#pragma unroll
            for (int et = 0; et < 4; ++et) { const int e = eh * 64 + et * 16 + fr;
#pragma unroll
                for (int ks = 0; ks < 2; ++ks) { const bf16x8 bv = *(const LAS bf16x8*)(vT + e * LP + ks * 32 + fq * 8); acco[et] = __builtin_amdgcn_mfma_f32_16x16x32_bf16(aa[ks], bv, acco[et], 0, 0, 0); }
#pragma unroll
                for (int ks = 0; ks < 2; ++ks) { const bf16x8 bs = *(const bf16x8*)(sT + (size_t)e * 64 + ks * 32 + fq * 8); acco[et] = __builtin_amdgcn_mfma_f32_16x16x32_bf16(aq[ks], bs, acco[et], 0, 0, 0); } }
            __syncthreads();
        }
        float ss[4];
#pragma unroll
        for (int j = 0; j < 4; ++j) { float t = 0.f;
#pragma unroll
            for (int et = 0; et < 4; ++et) t += acco[et][j] * acco[et][j];
            t += __shfl_xor(t, 1); t += __shfl_xor(t, 2); t += __shfl_xor(t, 4); t += __shfl_xor(t, 8); ss[j] = t; }
        if (fr == 0) {
#pragma unroll
            for (int j = 0; j < 4; ++j) red[eh * 64 + ct * 16 + fq * 4 + j] = ss[j]; }
        __syncthreads();
#pragma unroll
        for (int j = 0; j < 4; ++j) { const int c = ct * 16 + fq * 4 + j; const float rstd = rsqrtf((red[c] + red[64 + c]) * (1.f / 128.f) + 1e-6f);
            const bf16_t* rrow = PA + (size_t)(r0 + c) * PAW + PA_R + h * 128; bf16_t* orow = GO + (size_t)(r0 + c) * 512 + h * 128;
#pragma unroll
            for (int et = 0; et < 4; ++et) { const int e = eh * 64 + et * 16 + fr; const float rg = bf2f(rrow[e]);
                orow[e] = (bf16_t)f2bf(acco[et][j] * rstd * gnw[e] * siluf_(rg)); } }
        __syncthreads();
    }
}


template <int PH> __global__ void __launch_bounds__(512, 2) k_phase(Params p, int l) {
    extern __shared__ __attribute__((aligned(16))) unsigned char lds_raw[];
    LAS unsigned char* lds = (LAS unsigned char*)lds_raw;
    unsigned char* ws = p.ws;
    bf16_t* H = (bf16_t*)(ws + WS_H); bf16_t* ACT = (bf16_t*)(ws + WS_PA); bf16_t* PA = (bf16_t*)(ws + WS_PA); bf16_t* PG = (bf16_t*)(ws + WS_PG);
    bf16_t* MG = (bf16_t*)(ws + WS_PA); bf16_t* P = (bf16_t*)(ws + WS_P); bf16_t* GO = (bf16_t*)(ws + WS_H);
    float* xc = (float*)(ws + WS_CX); const float* MOD = (const float*)(ws + WS_MOD);
    const unsigned char* wl = ws + WS_W + (size_t)l * WL_SIZE; const float* modl = MOD + (size_t)l * 3 * NMOD;
    if constexpr (PH == 0) phase0(p, lds);
    if constexpr (PH == 1) norm_phase(p, l, 0);
    if constexpr (PH == 2) run_gemm(lds, H, (const bf16_t*)(wl + WL_UP1), 2 * DFF, D, EpiSwiGLU{ACT});
    if constexpr (PH == 3) run_gemm(lds, ACT, (const bf16_t*)(wl + WL_DN1), D, DFF, EpiResid{p.out, xc, modl + 2 * D, 0.5f});
    if constexpr (PH == 4) norm_phase(p, l, 1);
    if constexpr (PH == 5) { run_gemm(lds, H, (const bf16_t*)(wl + WL_WIN), 4096, D, EpiProj{PA, PG}); lowrank_phase(p, l); }
    if constexpr (PH == 6) gla_kv_phase(p, l, lds);
    if constexpr (PH == 7) gla_scan_phase(p);
    if constexpr (PH == 8) gla_out_phase(p, l, lds);
    if constexpr (PH == 9) run_gemm(lds, P, (const bf16_t*)(wl + WL_WPT), D, 512, EpiBranch{MG, PG, 0, 0});
    if constexpr (PH == 10) run_gemm(lds, GO, (const bf16_t*)(wl + WL_WGT), D, 512, EpiBranch{MG, PG, 1024, 1});
    if constexpr (PH == 11) run_gemm(lds, MG, (const bf16_t*)(wl + WL_WOT), D, D, EpiResid{p.out, xc, modl + 5 * D, 1.0f});
    if constexpr (PH == 12) norm_phase(p, l, 2);
    if constexpr (PH == 13) run_gemm(lds, H, (const bf16_t*)(wl + WL_UP2), 2 * DFF, D, EpiSwiGLU{ACT});
    if constexpr (PH == 14) run_gemm(lds, ACT, (const bf16_t*)(wl + WL_DN2), D, DFF, EpiResid{p.out, xc, modl + 8 * D, 0.5f});
    if constexpr (PH == 15) final_norm(p);
}
template <int PH> static bool launch_phase(const Params& p, int l, hipStream_t stream) {
    static bool attr_set = false;
    if (!attr_set) { if (hipFuncSetAttribute((const void*)k_phase<PH>, hipFuncAttributeMaxDynamicSharedMemorySize, LDS_BYTES) != hipSuccess) { fprintf(stderr, "hipFuncSetAttribute failed for phase %d\n", PH); return false; } attr_set = true; }
    hipLaunchKernelGGL(k_phase<PH>, dim3(256), dim3(512), LDS_BYTES, stream, p, l);
    return true;
}
extern "C" void kernel_launch(void* const* d_in, const int* in_sizes, int n_in, void* d_out, int out_size, void* d_ws, size_t ws_size, hipStream_t stream) {
    if (n_in != 23 || out_size != RL * D || ws_size < WS_END) { fprintf(stderr, "kernel_launch: unexpected sizes (n_in %d out %d ws %zu need %zu)\n", n_in, out_size, ws_size, (size_t)WS_END); return; }
    Params p{};
    const float** pp = (const float**)&p;
    for (int i = 0; i < 23; ++i) pp[i] = (const float*)d_in[i];
    p.out = (float*)d_out; p.ws = (unsigned char*)d_ws;
    launch_phase<0>(p, 0, stream);
    for (int l = 0; l < DEPTH; ++l) {
        launch_phase<1>(p, l, stream); launch_phase<2>(p, l, stream); launch_phase<3>(p, l, stream); launch_phase<4>(p, l, stream); launch_phase<5>(p, l, stream);
        launch_phase<6>(p, l, stream); launch_phase<7>(p, l, stream); launch_phase<8>(p, l, stream); launch_phase<9>(p, l, stream); launch_phase<10>(p, l, stream);
        launch_phase<11>(p, l, stream); launch_phase<12>(p, l, stream); launch_phase<13>(p, l, stream); launch_phase<14>(p, l, stream);
    }
    launch_phase<15>(p, 0, stream);
}
```

```cpp
#include <hip/hip_runtime.h>
#include <hip/hip_cooperative_groups.h>
#include <cstdio>
namespace cg = cooperative_groups;
__device__ __forceinline__ int otid() { int t = (int)threadIdx.x; asm volatile("" : "+v"(t)); return t; }
namespace pg8 {
#define PG8_LAS __attribute__((address_space(3)))
typedef unsigned short bf16_t;
typedef short bf16x8 __attribute__((ext_vector_type(8)));
typedef float f32x4 __attribute__((ext_vector_type(4)));
typedef unsigned u32x4 __attribute__((ext_vector_type(4)));
constexpr int BM = 256, BK = 64, HALF = 128, HTB = HALF * BK * 2  , STAGE_BYTES = 8 * HTB, NXCD = 8, WGM = 8;

__host__ __device__ __forceinline__ int lds_byte(int r, int c) { const int st = (r >> 4) * 2 + (c >> 5), rr = r & 15, cc = c & 31, ob = rr * 64 + cc * 2; return st * 1024 + (ob ^ (((ob >> 9) & 1) << 5)); }
__host__ __device__ __forceinline__ void stage_rc(int b, int& R, int& C) { const int st = b / 1024, sb = b % 1024, swz = sb ^ (((sb >> 9) & 1) << 5); R = (st >> 1) * 16 + swz / 64; C = (st & 1) * 32 + (swz % 64) / 2; }
__host__ __device__ __forceinline__ int perm32(int rho) { const int n = rho >> 4, i = rho & 15; return 8 * (i >> 2) + 4 * n + (i & 3); }

struct Unit { int pm, pn, kt0, nkt; };
struct Gemm { const bf16_t* A; const bf16_t* Bt; int M, N, K; };

struct StaticOrder {
    int nM, nN, nwg, G, c, nkt_full;
    __host__ __device__ void init(int M, int N, int G_, int c_) { nM = M / BM; nN = N / BM; nwg = nM * nN; G = G_; c = c_; }
    __host__ __device__ bool next(int i, Unit& u) const {
        const long L = (long)i * G + c; if (L >= nwg) return false;
        int wgid = (int)L; { const int q = nwg / NXCD, r = nwg % NXCD, xcd = wgid % NXCD, off = wgid / NXCD; wgid = (xcd < r ? xcd * (q + 1) : r * (q + 1) + (xcd - r) * q) + off; }
        const int nig = WGM * nN, gid = wgid / nig, fm = gid * WGM, gsz = (nM - fm) < WGM ? (nM - fm) : WGM;
        u.pm = fm + ((wgid % nig) % gsz); u.pn = (wgid % nig) / gsz; u.kt0 = 0; u.nkt = nkt_full; return true;
    }
    __device__ __forceinline__ void a_ready(const Unit&) const {}
    __device__ __forceinline__ void done(const Unit&) const {}
};
__device__ __forceinline__ unsigned cvt_pk_bf16(float lo, float hi) { unsigned r; asm volatile("v_cvt_pk_bf16_f32 %0, %1, %2" : "=v"(r) : "v"(lo), "v"(hi)); return r; }
typedef float f32x2 __attribute__((ext_vector_type(2)));

template <class Epi, class Sched, bool STAMP = false>
__device__ __forceinline__ void gemm_phase(PG8_LAS unsigned char* lds, const Gemm g, const Sched& S, const Epi& E, unsigned long long* stamps) {
    const int tid = otid(), wid = __builtin_amdgcn_readfirstlane(tid >> 6), lane = tid & 63, wr = wid >> 2, wc = wid & 3, fr = lane & 15, fq = lane >> 4;
    const int K = g.K;
    int ts_lo = 0, ts_hi = 0, nts = 0; const unsigned long long rt_entry = STAMP ? (unsigned long long)wall_clock64() : 0ull;
#define PG8_STAMP() do { if (STAMP && wid == 0 && nts < 64) { const unsigned long long _c = (unsigned long long)clock64(); \
        ts_lo = (lane == nts) ? (int)(unsigned)_c : ts_lo; ts_hi = (lane == nts) ? (int)(unsigned)(_c >> 32) : ts_hi; ++nts; } } while (0)
    PG8_STAMP();
    unsigned voffA[2], voffB[2];
#pragma unroll
    for (int i = 0; i < 2; ++i) { int R, C; stage_rc(tid * 16 + i * 8192, R, C); const int Rb = Epi::PERM ? ((R & ~31) + perm32(R & 31)) : R;
        voffA[i] = (unsigned)(R * K + C) * 2u; voffB[i] = (unsigned)(Rb * K + C) * 2u; }
    const size_t kstep = (size_t)(BK * 2);
    const size_t hstep = (size_t)HALF * K * 2;
    const size_t tstep = 2 * hstep;
    const unsigned ldsw = (unsigned)wid * 1024u;
    const int aoff = lds_byte(wr * 64 + fr, fq * 8), boff = lds_byte(wc * 32 + fr, fq * 8);
#define PG8_SA(b, h) (((b) * 2 + (h)) * HTB)
#define PG8_SB(b, h) ((4 + (b) * 2 + (h)) * HTB)
#define PG8_STAGE(bufoff, gbase, voff) do { _Pragma("unroll") for (int _i = 0; _i < 2; ++_i) \
        __builtin_amdgcn_global_load_lds((const unsigned*)((const char*)(gbase) + (voff)[_i]), (PG8_LAS unsigned*)(lds + (bufoff) + ldsw + _i * 8192), 16, 0, 0); } while (0)
#define PG8_LDA(dst, b, h) do { _Pragma("unroll") for (int m = 0; m < 4; ++m) _Pragma("unroll") for (int k = 0; k < 2; ++k) dst[m][k] = *(const PG8_LAS bf16x8*)(lds + PG8_SA(b, h) + aoff + m * 2048 + k * 1024); } while (0)
#define PG8_LDB(dst, b, h) do { _Pragma("unroll") for (int n = 0; n < 2; ++n) _Pragma("unroll") for (int k = 0; k < 2; ++k) dst[n][k] = *(const PG8_LAS bf16x8*)(lds + PG8_SB(b, h) + boff + n * 2048 + k * 1024); } while (0)
#define PG8_MMA(ai, bj, At, Bt) do { __builtin_amdgcn_s_setprio(1); _Pragma("unroll") for (int m = 0; m < 4; ++m) _Pragma("unroll") for (int n = 0; n < 2; ++n) _Pragma("unroll") for (int k = 0; k < 2; ++k) \
        acc[ai][bj][m][n] = __builtin_amdgcn_mfma_f32_16x16x32_bf16(Bt[n][k], At[m][k], acc[ai][bj][m][n], 0, 0, 0); __builtin_amdgcn_s_setprio(0); } while (0)
#define PG8_WAIT_V(n) asm volatile("s_waitcnt vmcnt(" #n ")" ::: "memory")
#define PG8_WAIT_L(n) asm volatile("s_waitcnt lgkmcnt(" #n ")" ::: "memory")
#define PG8_BAR __builtin_amdgcn_s_barrier()
#define PG8_SCHED __builtin_amdgcn_sched_barrier(0)
    Unit cur, nxt; int ui = 0;
    if (!S.next(0, cur)) return;
    f32x4 acc[2][2][4][2];
    float pf[Epi::NPF > 0 ? Epi::NPF : 1];
#pragma unroll
    for (int a = 0; a < 2; ++a)
#pragma unroll
        for (int b = 0; b < 2; ++b)
#pragma unroll
            for (int m = 0; m < 4; ++m)
#pragma unroll
                for (int n = 0; n < 2; ++n) acc[a][b][m][n] = (f32x4){0.f, 0.f, 0.f, 0.f};
    bf16x8 At[4][2], B0[2][2], B1[2][2];
    const char* cA = (const char*)g.A + (size_t)cur.pm * tstep + (size_t)cur.kt0 * kstep; const char* cB = (const char*)g.Bt + (size_t)cur.pn * tstep + (size_t)cur.kt0 * kstep;
    S.a_ready(cur);
    PG8_STAGE(PG8_SB(0, 0), cB, voffB); PG8_STAGE(PG8_SA(0, 0), cA, voffA); PG8_STAGE(PG8_SB(0, 1), cB + hstep, voffB); PG8_STAGE(PG8_SA(0, 1), cA + hstep, voffA);
    if (wr == 1) PG8_BAR;
    PG8_WAIT_V(4); PG8_BAR;
    PG8_STAGE(PG8_SB(1, 0), cB + kstep, voffB); PG8_STAGE(PG8_SA(1, 0), cA + kstep, voffA); PG8_STAGE(PG8_SB(1, 1), cB + hstep + kstep, voffB);
    PG8_WAIT_V(6); PG8_BAR;
    PG8_STAMP();
    for (;;) {
        const bool has_next = S.next(ui + 1, nxt);
        const char* nA = has_next ? (const char*)g.A + (size_t)nxt.pm * tstep + (size_t)nxt.kt0 * kstep : cA; const char* nB = has_next ? (const char*)g.Bt + (size_t)nxt.pn * tstep + (size_t)nxt.kt0 * kstep : cB;
        const int nt = cur.nkt;
        for (int t = 0; t < nt; t += 2) {
            const bool last = (t == nt - 2);
            const char* a1 = cA + (size_t)(t + 1) * kstep;
            const char* a2 = last ? nA : cA + (size_t)(t + 2) * kstep; const char* b2 = last ? nB : cB + (size_t)(t + 2) * kstep;
            const char* a3 = a2 + kstep; const char* b3 = b2 + kstep;
            if (last && has_next) S.a_ready(nxt);
            if constexpr (Epi::NPF > 0) { if (last) E.prefetch(cur, wr, wc, fr, fq, pf); }
            PG8_LDB(B0, 0, 0); PG8_SCHED; PG8_LDA(At, 0, 0); PG8_STAGE(PG8_SA(1, 1), a1 + hstep, voffA);
            PG8_WAIT_L(8); PG8_BAR; PG8_WAIT_L(0); PG8_MMA(0, 0, At, B0); PG8_BAR; PG8_SCHED;
            PG8_LDB(B1, 0, 1); PG8_STAGE(PG8_SB(0, 0), b2, voffB);
            PG8_BAR; PG8_WAIT_L(0); PG8_MMA(0, 1, At, B1); PG8_BAR;
            PG8_LDA(At, 0, 1); PG8_STAGE(PG8_SA(0, 0), a2, voffA);
            PG8_BAR; PG8_WAIT_L(0); PG8_MMA(1, 0, At, B0); PG8_BAR; PG8_SCHED;
            PG8_STAGE(PG8_SB(0, 1), b2 + hstep, voffB);
            PG8_WAIT_V(6); PG8_BAR; PG8_MMA(1, 1, At, B1); PG8_BAR;
            PG8_LDB(B0, 1, 0); PG8_SCHED; PG8_LDA(At, 1, 0); PG8_STAGE(PG8_SA(0, 1), a2 + hstep, voffA);
            PG8_WAIT_L(8); PG8_BAR; PG8_WAIT_L(0); PG8_MMA(0, 0, At, B0); PG8_BAR; PG8_SCHED;
            PG8_LDB(B1, 1, 1); PG8_STAGE(PG8_SB(1, 0), b3, voffB);
            PG8_BAR; PG8_WAIT_L(0); PG8_MMA(0, 1, At, B1); PG8_BAR;
            PG8_LDA(At, 1, 1); PG8_STAGE(PG8_SA(1, 0), a3, voffA);
            PG8_BAR; PG8_WAIT_L(0); PG8_MMA(1, 0, At, B0); PG8_BAR; PG8_SCHED;
            PG8_STAGE(PG8_SB(1, 1), b3 + hstep, voffB);
            PG8_WAIT_V(6); PG8_BAR; PG8_MMA(1, 1, At, B1); PG8_BAR;
        }
        PG8_STAMP();
        if constexpr (!Epi::AFTER_DRAIN) { if constexpr (Epi::NPF > 0) E(acc, cur, wr, wc, fr, fq, pf); else E(acc, cur, wr, wc, fr, fq); S.done(cur); }
        PG8_STAMP();
        if (!has_next) break;
#pragma unroll
        for (int a = 0; a < 2; ++a)
#pragma unroll
            for (int b = 0; b < 2; ++b)
#pragma unroll
                for (int m = 0; m < 4; ++m)
#pragma unroll
                    for (int n = 0; n < 2; ++n) acc[a][b][m][n] = (f32x4){0.f, 0.f, 0.f, 0.f};
        cur = nxt; cA = nA; cB = nB; ++ui;
    }
    PG8_WAIT_V(0);
    if (wr == 0) PG8_BAR;
    PG8_BAR;
    if constexpr (Epi::AFTER_DRAIN) { E.fused(acc, cur, wr, wc, fr, fq, lds, wid, lane); S.done(cur); }
    PG8_STAMP();
    if (STAMP && wid == 0) { stamps[lane] = lane < nts ? (((unsigned long long)(unsigned)ts_hi << 32) | (unsigned)ts_lo) : 0ull;
        if (lane == 62) stamps[62] = rt_entry; if (lane == 63) stamps[63] = (unsigned long long)wall_clock64(); }
#undef PG8_STAMP
#undef PG8_SA
#undef PG8_SB
#undef PG8_STAGE
#undef PG8_LDA
#undef PG8_LDB
#undef PG8_MMA
#undef PG8_WAIT_V
#undef PG8_WAIT_L
#undef PG8_BAR
#undef PG8_SCHED
}
}

#define LAS __attribute__((address_space(3)))
typedef unsigned short bf16_t;
typedef short bf16x8 __attribute__((ext_vector_type(8)));
typedef float f32x4 __attribute__((ext_vector_type(4)));
typedef unsigned u32x4 __attribute__((ext_vector_type(4)));
typedef unsigned u32x2 __attribute__((ext_vector_type(2)));

constexpr int D = 1024, SEQ = 8192, NB = 2, CTXL = 256, DFF = 2816, DEPTH = 2;
constexpr int RL = NB * SEQ;
constexpr int RC = NB * CTXL;
constexpr int R = RL + RC;
constexpr int INC = 4128;
constexpr int OFF_K = 0, OFF_V = 256, OFF_AF = 768, OFF_Q = 800, OFF_R = 1056, OFF_POOL = 1568, OFF_GP = 2080, OFF_GG = 3104;
constexpr int PA_K = 0, PA_V = 256, PA_Q = 768, PA_R = 1024, PA_P = 1536, PAW = 2048;
constexpr int NCHUNK = R / 64;
constexpr int NITEM = NCHUNK * 4 * 2;
constexpr int NMOD = 9 * D;

constexpr size_t WL_UP1 = 0, WL_DN1 = 11534336, WL_WIN = 17301504, WL_LRT = 25690112, WL_WPT = 25755648, WL_WGT = 26804224,
                 WL_WOT = 27852800, WL_UP2 = 29949952, WL_DN2 = 41484288, WL_SIZE = 47251456;
constexpr size_t WS_W = 0;
constexpr size_t WS_H = WS_W + 2 * WL_SIZE;
constexpr size_t WS_PA = WS_H + (size_t)R * 1024 * 2;
constexpr size_t WS_PG = WS_PA + (size_t)R * 2048 * 2;
constexpr size_t WS_KV = WS_PG + (size_t)R * 2048 * 2;
constexpr size_t WS_P = WS_KV + (size_t)NITEM * 8192 * 2;
constexpr size_t WS_LR = WS_P + (size_t)R * 512 * 2;
constexpr size_t WS_CX = WS_LR + (size_t)R * 32 * 4;
constexpr size_t WS_MOD = WS_CX + (size_t)RC * 1024 * 4;
constexpr size_t WS_DEC = WS_MOD + (size_t)DEPTH * 3 * NMOD * 4;
constexpr size_t WS_SQ = WS_DEC + (size_t)NITEM * 64 * 4;
constexpr size_t WS_BIAS = WS_SQ + (size_t)6 * RL * 4;
constexpr int B_UP1 = 0, B_WIN = 2 * 5632, B_LR = B_WIN + 2 * 4096, B_UP2 = B_LR + 2 * 32, BIAS_L = B_UP2 + 2 * 5632;
constexpr size_t WS_XCH = WS_BIAS + (size_t)DEPTH * BIAS_L * 4;
constexpr size_t WS_END = WS_XCH + (size_t)64 * 4 * 256 * 4;
constexpr size_t WS_SP = WS_PA + (size_t)R * 2816 * 2;
static_assert(WS_SP + (size_t)11 * RC * 1024 * 4 <= WS_KV, "split-K scratch fits");
constexpr int LDS_BYTES = 147456;

struct Params {
    const float *x, *c, *ctx, *c_ctx, *w_mod, *b_mod, *norm_w, *ffn1_up, *ffn1_down, *w_in, *w_af_up, *b_af, *w_ab_up, *b_ab,
                *gla_norm_w, *pool_w, *pool_scale, *w_br_pool, *w_br_gla, *w_out, *ffn2_up, *ffn2_down, *final_norm_w;
    float* out; unsigned char* ws;
};

typedef __bf16 bf16x2_t __attribute__((ext_vector_type(2)));
__device__ __forceinline__ unsigned pk2(float lo, float hi) { bf16x2_t v = {(__bf16)lo, (__bf16)hi}; return __builtin_bit_cast(unsigned, v); }
__device__ __forceinline__ unsigned f2bf(float f) { return (unsigned)__builtin_bit_cast(unsigned short, (__bf16)f); }
__device__ __forceinline__ float bf2f(unsigned short b) { return __builtin_bit_cast(float, ((unsigned)b) << 16); }
__device__ __forceinline__ float bflo(unsigned w) { return __builtin_bit_cast(float, w << 16); }
__device__ __forceinline__ float bfhi(unsigned w) { return __builtin_bit_cast(float, w & 0xffff0000u); }
__device__ __forceinline__ float sigmoidf_(float v) { return __builtin_amdgcn_rcpf(1.f + __builtin_amdgcn_exp2f(-1.44269504f * v)); }
__device__ __forceinline__ float siluf_(float v) { return v * __builtin_amdgcn_rcpf(1.f + __builtin_amdgcn_exp2f(-1.44269504f * v)); }
__device__ __forceinline__ float log_sigmoidf_(float v) { return fminf(v, 0.f) - log1pf(__expf(-fabsf(v))); }
__device__ __forceinline__ float wave_sum(float v) {
#pragma unroll
    for (int o = 1; o < 64; o <<= 1) v += __shfl_xor(v, o);
    return v;
}
__device__ __forceinline__ int mod_index(int r) { return r < SEQ ? 0 : (r < RL ? 1 : 2); }
__device__ __forceinline__ float* xrow_ptr(float* xl, float* xc, int r) { return r < RL ? xl + (size_t)r * D : xc + (size_t)(r - RL) * D; }

struct EpiSwiGLU {
    static constexpr bool PERM = true, AFTER_DRAIN = false;
    bf16_t* O; const float* sq; const float* bias;
    static constexpr int NPF = 16;
    __device__ __forceinline__ void prefetch(const pg8::Unit u, int wr, int wc, int fr, int fq, float (&pf)[16]) const {
        const bool fz = (sq != nullptr) && (u.pm < 64); const int row0 = u.pm * 256 + wr * 64 + fr;
#pragma unroll
        for (int i = 0; i < 8; ++i) pf[i] = fz ? sq[row0 + (i >> 2) * 128 + (i & 3) * 16] : 0.f;
        const float* bp = bias + (u.pm >= 32 ? 2 * DFF : 0) + u.pn * 256 + wc * 32 + 8 * fq;
#pragma unroll
        for (int bj = 0; bj < 2; ++bj) { const f32x4 a = fz ? *(const f32x4*)(bp + bj * 128) : (f32x4){0.f, 0.f, 0.f, 0.f}, b = fz ? *(const f32x4*)(bp + bj * 128 + 4) : (f32x4){0.f, 0.f, 0.f, 0.f};
            pf[8 + bj * 4 + 0] = __builtin_bit_cast(float, pk2(a[0], a[1])); pf[8 + bj * 4 + 1] = __builtin_bit_cast(float, pk2(a[2], a[3]));
            pf[8 + bj * 4 + 2] = __builtin_bit_cast(float, pk2(b[0], b[1])); pf[8 + bj * 4 + 3] = __builtin_bit_cast(float, pk2(b[2], b[3])); }
    }
    __device__ __forceinline__ void operator()(const f32x4 (&acc)[2][2][4][2], const pg8::Unit u, int wr, int wc, int fr, int fq, const float (&pf)[16]) const {
        const int row0 = u.pm * 256 + wr * 64 + fr, col0 = u.pn * 128 + wc * 16 + 4 * fq;
        const bool fz = (sq != nullptr) && (u.pm < 64);
        f32x4 ba[2], bb[2];
#pragma unroll
        for (int bj = 0; bj < 2; ++bj) { const unsigned w0 = __builtin_bit_cast(unsigned, pf[8 + bj * 4]), w1 = __builtin_bit_cast(unsigned, pf[9 + bj * 4]), w2 = __builtin_bit_cast(unsigned, pf[10 + bj * 4]), w3 = __builtin_bit_cast(unsigned, pf[11 + bj * 4]);
            ba[bj] = (f32x4){bflo(w0), bfhi(w0), bflo(w1), bfhi(w1)}; bb[bj] = (f32x4){bflo(w2), bfhi(w2), bflo(w3), bfhi(w3)}; }
#pragma unroll
        for (int ai = 0; ai < 2; ++ai)
#pragma unroll
            for (int m = 0; m < 4; ++m) { const int r = row0 + ai * 128 + m * 16; bf16_t* rowp = O + (size_t)r * DFF + col0;
                const float rstd = fz ? rsqrtf(pf[ai * 4 + m] * (1.f / D) + 1e-6f) : 1.f;
#pragma unroll
                for (int bj = 0; bj < 2; ++bj) { const f32x4 a = acc[ai][bj][m][0] * rstd + ba[bj], b = acc[ai][bj][m][1] * rstd + bb[bj];
                    u32x2 w; w.x = pk2(siluf_(a[0]) * b[0], siluf_(a[1]) * b[1]); w.y = pk2(siluf_(a[2]) * b[2], siluf_(a[3]) * b[3]);
                    *(u32x2*)(rowp + bj * 64) = w; } }
    }
};
struct EpiResid { static constexpr int NPF = 0;
    static constexpr bool PERM = false, AFTER_DRAIN = false;
    float* xl; const float* xin; const float* gate; float* sp; bf16_t* Hn; const float* nwn; const float* scn; float* sqn; float coef;
    __device__ __forceinline__ void operator()(const f32x4 (&acc)[2][2][4][2], const pg8::Unit u, int wr, int wc, int fr, int fq) const {
        const int row0 = u.pm * 256 + wr * 64 + fr, col0 = u.pn * 256 + wc * 32 + 4 * fq;
        const bool fz = (Hn != nullptr) && (u.pm < 64);
        const bool ctxu = (u.pm >= 64);
        const int mi = u.pm < 32 ? 0 : (u.pm < 64 ? 1 : 2);
        f32x4 gc[2][2], wm[2][2];
#pragma unroll
        for (int bj = 0; bj < 2; ++bj)
#pragma unroll
            for (int n = 0; n < 2; ++n) { const int off = col0 + bj * 128 + n * 16; gc[bj][n] = *(const f32x4*)(gate + (size_t)mi * NMOD + off) * coef;
                wm[bj][n] = fz ? *(const f32x4*)(nwn + off) * (*(const f32x4*)(scn + (size_t)mi * NMOD + off) + 1.f) : (f32x4){0.f, 0.f, 0.f, 0.f}; }
#pragma unroll
        for (int ai = 0; ai < 2; ++ai)
#pragma unroll
            for (int mh = 0; mh < 2; ++mh) {
                f32x4 xv[2][2][2];
#pragma unroll
                for (int mm = 0; mm < 2; ++mm)
#pragma unroll
                    for (int bj = 0; bj < 2; ++bj)
#pragma unroll
                        for (int n = 0; n < 2; ++n) xv[mm][bj][n] = ctxu ? (f32x4){0.f, 0.f, 0.f, 0.f} : *(const f32x4*)(xin + (size_t)(row0 + ai * 128 + (mh * 2 + mm) * 16) * D + col0 + bj * 128 + n * 16);
#pragma unroll
                for (int mm = 0; mm < 2; ++mm) { const int m = mh * 2 + mm; const int r = row0 + ai * 128 + m * 16; float* rowp = xl + (size_t)r * D + col0;
                    float ss = 0.f;
#pragma unroll
                    for (int bj = 0; bj < 2; ++bj)
#pragma unroll
                        for (int n = 0; n < 2; ++n) { const int off = bj * 128 + n * 16; const f32x4 dv = gc[bj][n] * acc[ai][bj][m][n];
                            if (ctxu) { *(f32x4*)(sp + ((size_t)(u.kt0 / u.nkt) * RC + (r - RL)) * D + col0 + off) = dv; }
                            else { const f32x4 x = xv[mm][bj][n] + dv; *(f32x4*)(rowp + off) = x;
                                if (fz) { const f32x4 xw = x * wm[bj][n]; u32x2 o; o.x = pk2(xw[0], xw[1]); o.y = pk2(xw[2], xw[3]); *(u32x2*)(Hn + (size_t)r * D + col0 + off) = o;
                                    ss += (x[0] * x[0] + x[1] * x[1]) + (x[2] * x[2] + x[3] * x[3]); } } }
                    if (fz) { ss += __shfl_xor(ss, 16); ss += __shfl_xor(ss, 32); if (fq == 0) unsafeAtomicAdd(sqn + r, ss); } } }
    }
};
struct EpiFinal { static constexpr int NPF = 0;
    static constexpr bool PERM = false, AFTER_DRAIN = true;
    float* out; const float* xin; const float* gate; const float* fw; float* xch; unsigned* cnt; float coef;
    __device__ __forceinline__ void fused(const f32x4 (&acc)[2][2][4][2], const pg8::Unit u, int wr, int wc, int fr, int fq, LAS unsigned char* lds, int wid, int lane) const {
        const int row0 = u.pm * 256 + wr * 64 + fr, col0 = u.pn * 256 + wc * 32 + 4 * fq, tid = wid * 64 + lane;
        const int mi = u.pm < 32 ? 0 : 1;
        LAS float* T = (LAS float*)lds; LAS float* RS = (LAS float*)(lds + 4096);
        f32x4 gc[2][2];
#pragma unroll
        for (int bj = 0; bj < 2; ++bj)
#pragma unroll
            for (int n = 0; n < 2; ++n) gc[bj][n] = *(const f32x4*)(gate + (size_t)mi * NMOD + col0 + bj * 128 + n * 16) * coef;
        f32x4 xn[2][2][4][2];
#pragma unroll
        for (int ai = 0; ai < 2; ++ai)
#pragma unroll
            for (int mh = 0; mh < 2; ++mh) {
                f32x4 xv[2][2][2];
#pragma unroll
                for (int mm = 0; mm < 2; ++mm)
#pragma unroll
                    for (int bj = 0; bj < 2; ++bj)
#pragma unroll
                        for (int n = 0; n < 2; ++n) xv[mm][bj][n] = *(const f32x4*)(xin + (size_t)(row0 + ai * 128 + (mh * 2 + mm) * 16) * D + col0 + bj * 128 + n * 16);
#pragma unroll
                for (int mm = 0; mm < 2; ++mm) { const int m = mh * 2 + mm; float ss = 0.f;
#pragma unroll
                    for (int bj = 0; bj < 2; ++bj)
#pragma unroll
                        for (int n = 0; n < 2; ++n) { const f32x4 x = xv[mm][bj][n] + gc[bj][n] * acc[ai][bj][m][n]; xn[ai][bj][m][n] = x; ss += (x[0] * x[0] + x[1] * x[1]) + (x[2] * x[2] + x[3] * x[3]); }
                    ss += __shfl_xor(ss, 16); ss += __shfl_xor(ss, 32);
                    if (fq == 0) T[(ai * 128 + wr * 64 + m * 16 + fr) * 4 + wc] = ss; } }
        __syncthreads();
        float* slot = xch + (size_t)(u.pm * 4 + u.pn) * 256;
        if (tid < 256) { const float t = (T[tid * 4 + 0] + T[tid * 4 + 1]) + (T[tid * 4 + 2] + T[tid * 4 + 3]); __hip_atomic_store(slot + tid, t, __ATOMIC_RELAXED, __HIP_MEMORY_SCOPE_AGENT); }
        asm volatile("s_waitcnt vmcnt(0)" ::: "memory");
        __syncthreads();
        if (tid == 0) { __hip_atomic_fetch_add(cnt + u.pm * 64, 1u, __ATOMIC_RELAXED, __HIP_MEMORY_SCOPE_AGENT);
            unsigned polls = 0; while (__hip_atomic_load(cnt + u.pm * 64, __ATOMIC_RELAXED, __HIP_MEMORY_SCOPE_AGENT) < 4u) { if (++polls > (1u << 20)) break; __builtin_amdgcn_s_sleep(1); }
            __builtin_amdgcn_fence(__ATOMIC_ACQUIRE, "agent"); asm volatile("s_waitcnt vmcnt(0)" ::: "memory"); }
        __syncthreads();
        if (tid < 256) { const float* base = xch + (size_t)(u.pm * 4) * 256 + tid; float t = 0.f;
#pragma unroll
            for (int q = 0; q < 4; ++q) t += __hip_atomic_load(base + q * 256, __ATOMIC_RELAXED, __HIP_MEMORY_SCOPE_AGENT);
            RS[tid] = rsqrtf(t * (1.f / D) + 1e-6f); }
        __syncthreads();
        f32x4 w4[2][2];
#pragma unroll
        for (int bj = 0; bj < 2; ++bj)
#pragma unroll
            for (int n = 0; n < 2; ++n) w4[bj][n] = *(const f32x4*)(fw + col0 + bj * 128 + n * 16);
#pragma unroll
        for (int ai = 0; ai < 2; ++ai)
#pragma unroll
            for (int m = 0; m < 4; ++m) { const float rstd = RS[ai * 128 + wr * 64 + m * 16 + fr]; float* rowp = out + (size_t)(row0 + ai * 128 + m * 16) * D + col0;
#pragma unroll
                for (int bj = 0; bj < 2; ++bj)
#pragma unroll
                    for (int n = 0; n < 2; ++n) *(f32x4*)(rowp + bj * 128 + n * 16) = (xn[ai][bj][m][n] * rstd) * w4[bj][n]; }
    }
};
struct EpiProj {
    static constexpr bool PERM = true, AFTER_DRAIN = false;
    bf16_t* O0; bf16_t* O1; const float* sq; const float* bias;
    static constexpr int NPF = 16;
    __device__ __forceinline__ void prefetch(const pg8::Unit u, int wr, int wc, int fr, int fq, float (&pf)[16]) const {
        const bool fz = (sq != nullptr) && (u.pm < 64); const int row0 = u.pm * 256 + wr * 64 + fr;
#pragma unroll
        for (int i = 0; i < 8; ++i) pf[i] = fz ? sq[row0 + (i >> 2) * 128 + (i & 3) * 16] : 0.f;
        const float* bp = bias + (u.pm >= 32 ? 4096 : 0) + u.pn * 256 + wc * 32 + 8 * fq;
#pragma unroll
        for (int bj = 0; bj < 2; ++bj) { const f32x4 a = fz ? *(const f32x4*)(bp + bj * 128) : (f32x4){0.f, 0.f, 0.f, 0.f}, b = fz ? *(const f32x4*)(bp + bj * 128 + 4) : (f32x4){0.f, 0.f, 0.f, 0.f};
            pf[8 + bj * 4 + 0] = __builtin_bit_cast(float, pk2(a[0], a[1])); pf[8 + bj * 4 + 1] = __builtin_bit_cast(float, pk2(a[2], a[3]));
            pf[8 + bj * 4 + 2] = __builtin_bit_cast(float, pk2(b[0], b[1])); pf[8 + bj * 4 + 3] = __builtin_bit_cast(float, pk2(b[2], b[3])); }
    }
    __device__ __forceinline__ void operator()(const f32x4 (&acc)[2][2][4][2], const pg8::Unit u, int wr, int wc, int fr, int fq, const float (&pf)[16]) const {
        const int row0 = u.pm * 256 + wr * 64 + fr; int colt = u.pn * 256; bf16_t* base = O0; if (colt >= 2048) { base = O1; colt -= 2048; }
        const int col0 = colt + wc * 32 + 8 * fq;
        const bool fz = (sq != nullptr) && (u.pm < 64);
        f32x4 b0[2], b1[2];
#pragma unroll
        for (int bj = 0; bj < 2; ++bj) { const unsigned w0 = __builtin_bit_cast(unsigned, pf[8 + bj * 4]), w1 = __builtin_bit_cast(unsigned, pf[9 + bj * 4]), w2 = __builtin_bit_cast(unsigned, pf[10 + bj * 4]), w3 = __builtin_bit_cast(unsigned, pf[11 + bj * 4]);
            b0[bj] = (f32x4){bflo(w0), bfhi(w0), bflo(w1), bfhi(w1)}; b1[bj] = (f32x4){bflo(w2), bfhi(w2), bflo(w3), bfhi(w3)}; }
#pragma unroll
        for (int ai = 0; ai < 2; ++ai)
#pragma unroll
            for (int m = 0; m < 4; ++m) { const int r = row0 + ai * 128 + m * 16; bf16_t* rowp = base + (size_t)r * PAW + col0;
                const float rstd = fz ? rsqrtf(pf[ai * 4 + m] * (1.f / D) + 1e-6f) : 1.f;
#pragma unroll
                for (int bj = 0; bj < 2; ++bj) { const f32x4 v0 = acc[ai][bj][m][0] * rstd + b0[bj], v1 = acc[ai][bj][m][1] * rstd + b1[bj];
                    u32x4 w; w.x = pk2(v0[0], v0[1]); w.y = pk2(v0[2], v0[3]); w.z = pk2(v1[0], v1[1]); w.w = pk2(v1[2], v1[3]);
                    *(u32x4*)(rowp + bj * 128) = w; } }
    }
};
struct EpiBranch { static constexpr int NPF = 0;
    static constexpr bool PERM = true, AFTER_DRAIN = false;
    bf16_t* MG; const bf16_t* PG; int goff; int accum;
    __device__ __forceinline__ void operator()(const f32x4 (&acc)[2][2][4][2], const pg8::Unit u, int wr, int wc, int fr, int fq) const {
        const int row0 = u.pm * 256 + wr * 64 + fr, col0 = u.pn * 256 + wc * 32 + 8 * fq;
#pragma unroll
        for (int ai = 0; ai < 2; ++ai)
#pragma unroll
          for (int mh = 0; mh < 2; ++mh) {
            u32x4 gv[2][2], ov[2][2];
#pragma unroll
            for (int mm = 0; mm < 2; ++mm)
#pragma unroll
                for (int bj = 0; bj < 2; ++bj) { const int r = row0 + ai * 128 + (mh * 2 + mm) * 16; gv[mm][bj] = *(const u32x4*)(PG + (size_t)r * PAW + goff + col0 + bj * 128);
                    ov[mm][bj] = accum ? *(const u32x4*)(MG + (size_t)r * 1024 + col0 + bj * 128) : (u32x4){0u, 0u, 0u, 0u}; }
#pragma unroll
            for (int mm = 0; mm < 2; ++mm) { const int m = mh * 2 + mm; const int r = row0 + ai * 128 + m * 16; bf16_t* rowp = MG + (size_t)r * 1024 + col0;
#pragma unroll
                for (int bj = 0; bj < 2; ++bj) { const f32x4 v0 = acc[ai][bj][m][0], v1 = acc[ai][bj][m][1];
                    const u32x4 g = gv[mm][bj], old = ov[mm][bj];
                    float o[8];
                    o[0] = sigmoidf_(bflo(g.x)) * v0[0]; o[1] = sigmoidf_(bfhi(g.x)) * v0[1]; o[2] = sigmoidf_(bflo(g.y)) * v0[2]; o[3] = sigmoidf_(bfhi(g.y)) * v0[3];
                    o[4] = sigmoidf_(bflo(g.z)) * v1[0]; o[5] = sigmoidf_(bfhi(g.z)) * v1[1]; o[6] = sigmoidf_(bflo(g.w)) * v1[2]; o[7] = sigmoidf_(bfhi(g.w)) * v1[3];
                    if (accum) { o[0] += bflo(old.x); o[1] += bfhi(old.x); o[2] += bflo(old.y); o[3] += bfhi(old.y); o[4] += bflo(old.z); o[5] += bfhi(old.z); o[6] += bflo(old.w); o[7] += bfhi(old.w); }
                    u32x4 w; w.x = pk2(o[0], o[1]); w.y = pk2(o[2], o[3]); w.z = pk2(o[4], o[5]); w.w = pk2(o[6], o[7]);
                    *(u32x4*)(rowp + bj * 128) = w; } } }
    }
};

struct CtxSplitOrder {
    pg8::StaticOrder M; int ksplit, nctx, nkt_part;
    __device__ void init(int N, int K, int G, int c, int ks) { M.init(RL, N, G, c); M.nkt_full = K / 64; ksplit = ks > 0 ? ks : 1; nctx = 2 * M.nN * ks; nkt_part = (K / 64) / ksplit; }
    __device__ bool next(int i, pg8::Unit& u) const {
        const long L = (long)i * M.G + M.c;
        if (L < M.nwg) return M.next(i, u);
        const int j = (int)(L - M.nwg); if (j >= nctx) return false;
        const int kp = j % ksplit, t = j / ksplit; u.pn = t % M.nN; u.pm = 64 + t / M.nN; u.kt0 = kp * nkt_part; u.nkt = nkt_part; return true;
    }
    __device__ __forceinline__ void a_ready(const pg8::Unit&) const {}
    __device__ __forceinline__ void done(const pg8::Unit&) const {}
};
template <class Epi>
__device__ __forceinline__ void run_gemm(LAS unsigned char* lds, int vblk, const bf16_t* A, const bf16_t* Bt, int N, int K, int ksplit, const Epi& E) {
    pg8::Gemm g{A, Bt, R, N, K}; CtxSplitOrder S; S.init(N, K, (int)gridDim.x, vblk, ksplit);
    pg8::gemm_phase<Epi, CtxSplitOrder, false>(lds, g, S, E, nullptr);
}

__device__ __forceinline__ int src_col(int kind, int n, float& sc) {
    sc = 1.f;
    if (kind == 0) return n;
    if (kind == 1) { const int q = n >> 3, e = n & 7; return e < 4 ? 4 * q + e : DFF + 4 * q + (e - 4); }
    if (kind == 2) { if (n < 256) return OFF_K + n; if (n < 768) return OFF_V + (n - 256); if (n < 1024) { sc = 0.125f; return OFF_Q + (n - 768); }
        if (n < 1536) return OFF_R + (n - 1024); if (n < 2048) return OFF_POOL + (n - 1536); if (n < 3072) return OFF_GP + (n - 2048); return OFF_GG + (n - 3072); }
    return OFF_AF + n;
}
__device__ __forceinline__ void tconv_job(const float* __restrict__ src, int ld, int K, int N, bf16_t* dst, int kind, LAS float* tile, int& base) {
    const int tid = otid(), G = gridDim.x;
    const int nnb = (N + 63) / 64, nt = (K / 64) * nnb;
    const int first = (((int)blockIdx.x - base) % G + G) % G;
    for (int t = first; t < nt; t += G) {
        const int k0 = (t / nnb) * 64, n0 = (t % nnb) * 64;
        { const int j = tid & 63, i0 = tid >> 6; float sc = 1.f; const bool ok = (n0 + j) < N; const int col = ok ? src_col(kind, n0 + j, sc) : 0;
#pragma unroll
          for (int i = 0; i < 8; ++i) { const int kk = i0 + 8 * i; tile[kk * 65 + j] = ok ? src[(size_t)(k0 + kk) * ld + col] * sc : 0.f; } }
        __syncthreads();
        { const int n = tid >> 3, ch = tid & 7; const LAS float* s = tile + (8 * ch) * 65 + n;
          if (n0 + n < N) { u32x4 o; o.x = pk2(s[0], s[65]); o.y = pk2(s[130], s[195]); o.z = pk2(s[260], s[325]); o.w = pk2(s[390], s[455]);
              *(u32x4*)(dst + (size_t)(n0 + n) * K + k0 + 8 * ch) = o; } }
        __syncthreads();
    }
    base += nt;
}

__device__ __forceinline__ void phase0(const Params& p, LAS unsigned char* lds) {
    const int tid = otid(), lane = tid & 63, wave = tid >> 6, G = gridDim.x;
    LAS float* tile = (LAS float*)lds;
    LAS float* scond = (LAS float*)(lds + 20480);
    LAS float* red = (LAS float*)(lds + 20480 + 12288);
    unsigned char* ws = p.ws;
    int base = 0;
    for (int l = 0; l < DEPTH; ++l) {
        unsigned char* wl = ws + WS_W + (size_t)l * WL_SIZE;
        tconv_job(p.ffn1_up + (size_t)l * D * 2 * DFF, 2 * DFF, D, 2 * DFF, (bf16_t*)(wl + WL_UP1), 1, tile, base);
        tconv_job(p.ffn1_down + (size_t)l * DFF * D, D, DFF, D, (bf16_t*)(wl + WL_DN1), 0, tile, base);
        tconv_job(p.w_in + (size_t)l * D * INC, INC, D, 4096, (bf16_t*)(wl + WL_WIN), 2, tile, base);
        tconv_job(p.w_in + (size_t)l * D * INC, INC, D, 32, (bf16_t*)(wl + WL_LRT), 3, tile, base);
        tconv_job(p.w_br_gla + (size_t)l * 512 * D, D, 512, D, (bf16_t*)(wl + WL_WGT), 0, tile, base);
        tconv_job(p.w_out + (size_t)l * D * D, D, D, D, (bf16_t*)(wl + WL_WOT), 0, tile, base);
        tconv_job(p.ffn2_up + (size_t)l * D * 2 * DFF, 2 * DFF, D, 2 * DFF, (bf16_t*)(wl + WL_UP2), 1, tile, base);
        tconv_job(p.ffn2_down + (size_t)l * DFF * D, D, DFF, D, (bf16_t*)(wl + WL_DN2), 0, tile, base);
    }
    const int gt = (int)blockIdx.x * 512 + tid, NT = G * 512;
    for (int idx = gt; idx < DEPTH * 512 * 256; idx += NT) {
        const int n4 = idx & 255, k = (idx >> 8) & 511, l = idx >> 17, g = k >> 7, kl = k & 127;
        const float* pw = p.pool_w + ((size_t)(l * 4 + g) * 128 + kl) * 128; const float* ps = p.pool_scale + l * 512 + g * 128;
        const float* wb = p.w_br_pool + ((size_t)l * 512 + g * 128) * D + n4 * 4;
        f32x4 a = {0.f, 0.f, 0.f, 0.f};
#pragma unroll 4
        for (int j = 0; j < 128; ++j) { const float s = pw[j] * ps[j]; a = a + *(const f32x4*)(wb + (size_t)j * D) * s; }
        bf16_t* d = (bf16_t*)(ws + WS_W + (size_t)l * WL_SIZE + WL_WPT) + (size_t)(n4 * 4) * 512 + k;
        d[0] = (bf16_t)f2bf(a[0]); d[512] = (bf16_t)f2bf(a[1]); d[1024] = (bf16_t)f2bf(a[2]); d[1536] = (bf16_t)f2bf(a[3]);
    }
    { float* sq = (float*)(ws + WS_SQ); for (int i = gt; i < 6 * RL; i += NT) sq[i] = 0.f; }
    for (int i = tid; i < 3 * D; i += 512) { const int mi = i >> 10, kk = i & 1023; const float v = mi < 2 ? p.c[mi * D + kk] : p.c_ctx[kk]; scond[i] = siluf_(v); }
    __syncthreads();
    float* MOD = (float*)(ws + WS_MOD);
    for (int it = G - 1 - (int)blockIdx.x; it < DEPTH * 144; it += G) {
        const int l = it / 144, n0 = (it % 144) * 64; const float* wm = p.w_mod + (size_t)l * D * NMOD + n0 + lane;
        float a0 = 0.f, a1 = 0.f, a2 = 0.f;
#pragma unroll 8
        for (int kk = wave; kk < D; kk += 8) { const float w = wm[(size_t)kk * NMOD]; a0 += scond[kk] * w; a1 += scond[D + kk] * w; a2 += scond[2 * D + kk] * w; }
        red[(wave * 3 + 0) * 64 + lane] = a0; red[(wave * 3 + 1) * 64 + lane] = a1; red[(wave * 3 + 2) * 64 + lane] = a2;
        __syncthreads();
        if (tid < 192) { const int mi = tid >> 6, j = tid & 63; float s = p.b_mod[l * NMOD + n0 + j];
#pragma unroll
            for (int w = 0; w < 8; ++w) s += red[(w * 3 + mi) * 64 + j];
            MOD[(size_t)(l * 3 + mi) * NMOD + n0 + j] = s; }
        __syncthreads();
    }
}

__device__ __forceinline__ void bias_rows(const bf16_t* Bt, int N, const float* sh, float* bo, int gw, int NGW, int lane) {
    float s0v[16], s1v[16];
#pragma unroll
    for (int i = 0; i < 8; ++i) { s0v[i] = sh[lane * 8 + i]; s0v[8 + i] = sh[512 + lane * 8 + i]; s1v[i] = sh[NMOD + lane * 8 + i]; s1v[8 + i] = sh[NMOD + 512 + lane * 8 + i]; }
    int n = gw;
    bf16x8 w0 = {0, 0, 0, 0, 0, 0, 0, 0}, w1 = w0;
    if (n < N) { w0 = *(const bf16x8*)(Bt + (size_t)n * D + lane * 8); w1 = *(const bf16x8*)(Bt + (size_t)n * D + 512 + lane * 8); }
    for (; n < N; n += NGW) {
        const int nn = n + NGW; bf16x8 x0 = w0, x1 = w1;
        if (nn < N) { x0 = *(const bf16x8*)(Bt + (size_t)nn * D + lane * 8); x1 = *(const bf16x8*)(Bt + (size_t)nn * D + 512 + lane * 8); }
        float s0 = 0.f, s1 = 0.f;
#pragma unroll
        for (int i = 0; i < 8; ++i) { const float a = bf2f((unsigned short)w0[i]), b = bf2f((unsigned short)w1[i]); s0 += a * s0v[i] + b * s0v[8 + i]; s1 += a * s1v[i] + b * s1v[8 + i]; }
        s0 = wave_sum(s0); s1 = wave_sum(s1);
        if (lane == 0) { bo[n] = s0; bo[N + n] = s1; }
        w0 = x0; w1 = x1;
    }
}
__device__ __forceinline__ void bias_phase(const Params& p) {
    const int tid = otid(), lane = tid & 63, wave = tid >> 6;
    const int gw = (int)blockIdx.x * 8 + wave, NGW = (int)gridDim.x * 8;
    for (int l = 0; l < DEPTH; ++l) {
        const unsigned char* wl = p.ws + WS_W + (size_t)l * WL_SIZE; const float* modl = (const float*)(p.ws + WS_MOD) + (size_t)l * 3 * NMOD; float* bl = (float*)(p.ws + WS_BIAS) + (size_t)l * BIAS_L;
        if (l > 0) bias_rows((const bf16_t*)(wl + WL_UP1), 5632, modl + 0 * D, bl + B_UP1, gw, NGW, lane);
        bias_rows((const bf16_t*)(wl + WL_WIN), 4096, modl + 3 * D, bl + B_WIN, gw, NGW, lane);
        bias_rows((const bf16_t*)(wl + WL_LRT), 32, modl + 3 * D, bl + B_LR, gw, NGW, lane);
        bias_rows((const bf16_t*)(wl + WL_UP2), 5632, modl + 6 * D, bl + B_UP2, gw, NGW, lane);
    }
}

__device__ __forceinline__ void norm_phase(const Params& p, int l, int which, int nsplit, int nrows, const float* xl_src, const float* xc_src, int ctx_only) {
    const int tid = otid(), lane = tid & 63, wave = tid >> 6;
    const int gw = (int)blockIdx.x * 8 + wave, NGW = (int)gridDim.x * 8;
    const float* nw = p.norm_w + (size_t)(l * 3 + which) * D;
    const float* MOD = (const float*)(p.ws + WS_MOD) + (size_t)l * 3 * NMOD;
    float* xc = (float*)(p.ws + WS_CX); bf16_t* H = (bf16_t*)(p.ws + WS_H);
    const int nctx = nrows - RL;
    const int nitems = ctx_only ? nctx : nrows;
    int it = gw;
    f32x4 v[4];
    if (it < nitems) { const int r = it < nctx ? RL + it : it - nctx; const f32x4* xr = (const f32x4*)(r < RL ? xl_src + (size_t)r * D : xc_src + (size_t)(r - RL) * D) + lane;
#pragma unroll
        for (int j = 0; j < 4; ++j) v[j] = xr[64 * j]; }
    for (; it < nitems; it += NGW) {
        const int r = it < nctx ? RL + it : it - nctx;
        const int itn = it + NGW; f32x4 vn[4];
#pragma unroll
        for (int j = 0; j < 4; ++j) vn[j] = v[j];
        if (itn < nitems) { const int rn = itn < nctx ? RL + itn : itn - nctx; const f32x4* xr = (const f32x4*)(rn < RL ? xl_src + (size_t)rn * D : xc_src + (size_t)(rn - RL) * D) + lane;
#pragma unroll
            for (int j = 0; j < 4; ++j) vn[j] = xr[64 * j]; }
        if (r >= RL && nsplit > 0) {
            const f32x4* sp = (const f32x4*)((const float*)(p.ws + WS_SP) + (size_t)(r - RL) * D) + lane;
            for (int kp0 = 0; kp0 < nsplit; kp0 += 4) { f32x4 t[4][4];
#pragma unroll
                for (int q = 0; q < 4; ++q) { const int kp = (kp0 + q < nsplit) ? kp0 + q : kp0;
#pragma unroll
                    for (int j = 0; j < 4; ++j) t[q][j] = sp[(size_t)kp * (RC * D / 4) + 64 * j]; }
#pragma unroll
                for (int q = 0; q < 4; ++q) { const float m = (kp0 + q < nsplit) ? 1.f : 0.f;
#pragma unroll
                    for (int j = 0; j < 4; ++j) v[j] = v[j] + t[q][j] * m; } }
            f32x4* xw = (f32x4*)(xc + (size_t)(r - RL) * D) + lane;
#pragma unroll
            for (int j = 0; j < 4; ++j) xw[64 * j] = v[j];
        }
        const float* mrow = MOD + (size_t)mod_index(r) * NMOD + (3 * which) * D;
        float s = 0.f;
#pragma unroll
        for (int j = 0; j < 4; ++j) s += (v[j][0] * v[j][0] + v[j][1] * v[j][1]) + (v[j][2] * v[j][2] + v[j][3] * v[j][3]);
        const float rstd = rsqrtf(wave_sum(s) * (1.f / D) + 1e-6f);
        u32x2* o8 = (u32x2*)(H + (size_t)r * D) + lane;
#pragma unroll
        for (int j = 0; j < 4; ++j) { const int c = 256 * j + 4 * lane;
            const f32x4 w = *(const f32x4*)(nw + c), sh = *(const f32x4*)(mrow + c), sc = *(const f32x4*)(mrow + D + c);
            const f32x4 h = (v[j] * rstd) * w * (sc + 1.f) + sh;
            u32x2 o; o.x = pk2(h[0], h[1]); o.y = pk2(h[2], h[3]); o8[64 * j] = o; }
#pragma unroll
        for (int j = 0; j < 4; ++j) v[j] = vn[j];
    }
}
__device__ __forceinline__ void final_norm(const Params& p) {
    const int tid = otid(), lane = tid & 63, wave = tid >> 6;
    const int gw = (int)blockIdx.x * 8 + wave, NGW = (int)gridDim.x * 8;
    int r = gw; f32x4 v[4];
    if (r < RL) { const f32x4* xr = (const f32x4*)(p.out + (size_t)r * D) + lane;
#pragma unroll
        for (int j = 0; j < 4; ++j) v[j] = xr[64 * j]; }
    for (; r < RL; r += NGW) {
        const int rn = r + NGW; f32x4 vn[4];
#pragma unroll
        for (int j = 0; j < 4; ++j) vn[j] = v[j];
        if (rn < RL) { const f32x4* xr = (const f32x4*)(p.out + (size_t)rn * D) + lane;
#pragma unroll
            for (int j = 0; j < 4; ++j) vn[j] = xr[64 * j]; }
        float s = 0.f;
#pragma unroll
        for (int j = 0; j < 4; ++j) s += (v[j][0] * v[j][0] + v[j][1] * v[j][1]) + (v[j][2] * v[j][2] + v[j][3] * v[j][3]);
        const float rstd = rsqrtf(wave_sum(s) * (1.f / D) + 1e-6f);
        f32x4* xo = (f32x4*)(p.out + (size_t)r * D) + lane;
#pragma unroll
        for (int j = 0; j < 4; ++j) { const f32x4 w = *(const f32x4*)(p.final_norm_w + 256 * j + 4 * lane); xo[64 * j] = (v[j] * rstd) * w; }
#pragma unroll
        for (int j = 0; j < 4; ++j) v[j] = vn[j];
    }
}

__device__ __forceinline__ void lowrank_phase(const Params& p, int l, int vblk, const float* sq, const float* bias) {
    const int tid = otid(), lane = tid & 63, wave = tid >> 6, fr = lane & 15, fq = lane >> 4;
    const int skip = (int)gridDim.x > 64 ? 32 : 0;
    if (vblk < skip) return;
    const int gw = (vblk - skip) * 8 + wave, NGW = ((int)gridDim.x - skip) * 8;
    const bf16_t* H = (const bf16_t*)(p.ws + WS_H); const bf16_t* lrt = (const bf16_t*)(p.ws + WS_W + (size_t)l * WL_SIZE + WL_LRT);
    float* LR = (float*)(p.ws + WS_LR);
    for (int it = gw; it < R / 16; it += NGW) {
        const int r0 = it * 16;
        const bf16_t* ap = H + (size_t)(r0 + fr) * D + fq * 8; const bf16_t* bp = lrt + (size_t)fr * D + fq * 8;
        f32x4 acc0 = {0.f, 0.f, 0.f, 0.f}, acc1 = {0.f, 0.f, 0.f, 0.f};
#pragma unroll 4
        for (int ks = 0; ks < 32; ++ks) { const bf16x8 a = *(const bf16x8*)(ap + ks * 32), b0 = *(const bf16x8*)(bp + ks * 32), b1 = *(const bf16x8*)(bp + 16 * D + ks * 32);
            acc0 = __builtin_amdgcn_mfma_f32_16x16x32_bf16(a, b0, acc0, 0, 0, 0); acc1 = __builtin_amdgcn_mfma_f32_16x16x32_bf16(a, b1, acc1, 0, 0, 0); }
        const bool fz = (sq != nullptr) && (r0 < RL);
        const float bl = fz ? bias[(r0 < SEQ ? 0 : 32) + fr] : 0.f, bh = fz ? bias[(r0 < SEQ ? 0 : 32) + 16 + fr] : 0.f;
#pragma unroll
        for (int j = 0; j < 4; ++j) { const int r = r0 + fq * 4 + j; const float rstd = fz ? rsqrtf(sq[r] * (1.f / D) + 1e-6f) : 1.f;
            float* o = LR + (size_t)r * 32 + fr; o[0] = acc0[j] * rstd + bl; o[16] = acc1[j] * rstd + bh; }
    }
}

#define LBAR() do { asm volatile("s_waitcnt lgkmcnt(0)" ::: "memory"); __builtin_amdgcn_s_barrier(); asm volatile("" ::: "memory"); } while (0)
#define LWAIT() asm volatile("s_waitcnt lgkmcnt(0)" ::: "memory")
constexpr int BP = 68;
constexpr int LP = 72;
constexpr int NGI = NCHUNK * 4;

struct GateIn { float a[4][4]; float bw[4]; float bias; };
__device__ __forceinline__ void gates_load(const Params& p, int l, int it, int lane, int wave, GateIn& g) {
    const int r0 = (it >> 2) * 64, h = it & 3, col = lane & 15, quad = lane >> 4, dir = wave >> 2, dkt = wave & 3;
    const float* LR = (const float*)(p.ws + WS_LR) + (size_t)r0 * 32 + dir * 16 + quad;
    const float* wup = (dir == 0 ? p.w_af_up : p.w_ab_up) + (size_t)l * 16 * 256 + h * 64 + dkt * 16 + col;
    g.bias = (dir == 0 ? p.b_af : p.b_ab)[l * 256 + h * 64 + dkt * 16 + col];
#pragma unroll
    for (int kq = 0; kq < 4; ++kq) g.bw[kq] = wup[(kq * 4 + quad) * 256];
#pragma unroll
    for (int ct = 0; ct < 4; ++ct)
#pragma unroll
        for (int kq = 0; kq < 4; ++kq) g.a[ct][kq] = LR[(size_t)(ct * 16 + col) * 32 + kq * 4];
}
__device__ __forceinline__ void gates_compute(const GateIn& gi, int lane, int wave, LAS float* Bf, LAS float* Bb) {
    const int col = lane & 15, quad = lane >> 4, dir = wave >> 2, dkt = wave & 3;
    float run = 0.f; float pex[4][4];
#pragma unroll
    for (int ct = 0; ct < 4; ++ct) {
        f32x4 acc = {gi.bias, gi.bias, gi.bias, gi.bias};
#pragma unroll
        for (int kq = 0; kq < 4; ++kq) acc = __builtin_amdgcn_mfma_f32_16x16x4f32(gi.a[ct][kq], gi.bw[kq], acc, 0, 0, 0);
        float g[4], pi[4];
#pragma unroll
        for (int j = 0; j < 4; ++j) { const float x = acc[j]; g[j] = (fminf(x, 0.f) - __logf(1.f + __expf(-fabsf(x)))) * (1.f / 16.f); }
        pi[0] = g[0]; pi[1] = pi[0] + g[1]; pi[2] = pi[1] + g[2]; pi[3] = pi[2] + g[3];
        const float t = pi[3];
        const float t0 = __shfl(t, col), t1 = __shfl(t, col + 16), t2 = __shfl(t, col + 32), t3 = __shfl(t, col + 48);
        const float offs = run + (quad > 0 ? t0 : 0.f) + (quad > 1 ? t1 : 0.f) + (quad > 2 ? t2 : 0.f);
        run += (t0 + t1) + (t2 + t3);
        if (dir == 0) {
#pragma unroll
            for (int j = 0; j < 4; ++j) Bf[(ct * 16 + quad * 4 + j) * BP + dkt * 16 + col] = offs + pi[j]; }
#pragma unroll
        for (int j = 0; j < 4; ++j) pex[ct][j] = offs + pi[j] - g[j];
    }
    if (dir == 1) {
#pragma unroll
        for (int ct = 0; ct < 4; ++ct)
#pragma unroll
            for (int j = 0; j < 4; ++j) Bb[(ct * 16 + quad * 4 + j) * BP + dkt * 16 + col] = run - pex[ct][j]; }
}

template <int HALF>
__device__ __forceinline__ void pool_vertical(const bf16_t* basep, int Rr, int col, float (&acc)[16], float (&uc)[16]) {
#pragma unroll
    for (int i = 0; i < 16; ++i) { acc[i] = 0.f; uc[i] = 0.f; }
#pragma unroll
    for (int o = -HALF; o < HALF; ++o) { const int rr = Rr + o; const bool ok = (rr >= 0) && (rr < 128); const int rc = ok ? rr : Rr;
        const bf16_t* pp = basep + (size_t)(rc * 64 + col) * PAW; const bf16x8 a0 = *(const bf16x8*)pp, a1 = *(const bf16x8*)(pp + 8);
        const float m = ok ? 1.f : 0.f;
#pragma unroll
        for (int i = 0; i < 8; ++i) { const float f0 = bf2f((unsigned short)a0[i]), f1 = bf2f((unsigned short)a1[i]); acc[i] += m * f0; acc[8 + i] += m * f1; if (o == 0) { uc[i] = f0; uc[8 + i] = f1; } } }
}

__device__ __forceinline__ void gla_kv_phase(const Params& p, int l, LAS unsigned char* lds) {
    const int tid = otid(), lane = tid & 63, wave = tid >> 6, fr = lane & 15, fq = lane >> 4, G = gridDim.x;
    LAS float* Bf = (LAS float*)lds; LAS float* Bb = (LAS float*)(lds + 17408);
    LAS bf16_t* keT0 = (LAS bf16_t*)(lds + 34816); LAS bf16_t* keT1 = (LAS bf16_t*)(lds + 34816 + 9216); LAS bf16_t* vT = (LAS bf16_t*)(lds + 34816 + 18432);
    const bf16_t* PA = (const bf16_t*)(p.ws + WS_PA); bf16_t* KV = (bf16_t*)(p.ws + WS_KV); float* DEC = (float*)(p.ws + WS_DEC);
    const int c = tid & 63, sub = tid >> 6;
    GateIn gc; bf16x8 kk = {0, 0, 0, 0, 0, 0, 0, 0}, v0 = kk, v1 = kk;
    int it = blockIdx.x;
    if (it < NGI) { gates_load(p, l, it, lane, wave, gc); const bf16_t* rowp = PA + (size_t)((it >> 2) * 64 + c) * PAW; const int h = it & 3;
        kk = *(const bf16x8*)(rowp + PA_K + h * 64 + sub * 8); v0 = *(const bf16x8*)(rowp + PA_V + h * 128 + sub * 16); v1 = *(const bf16x8*)(rowp + PA_V + h * 128 + sub * 16 + 8); }
    for (; it < NGI; it += G) {
        const int nit = it + G; GateIn gn = gc; bf16x8 nkk = kk, nv0 = v0, nv1 = v1;
        if (nit < NGI) { gates_load(p, l, nit, lane, wave, gn); const bf16_t* rowp = PA + (size_t)((nit >> 2) * 64 + c) * PAW; const int h = nit & 3;
            nkk = *(const bf16x8*)(rowp + PA_K + h * 64 + sub * 8); nv0 = *(const bf16x8*)(rowp + PA_V + h * 128 + sub * 16); nv1 = *(const bf16x8*)(rowp + PA_V + h * 128 + sub * 16 + 8); }
        gates_compute(gc, lane, wave, Bf, Bb);
        LBAR();
        { const f32x4 bf0 = *(const LAS f32x4*)(Bf + c * BP + sub * 8), bf1 = *(const LAS f32x4*)(Bf + c * BP + sub * 8 + 4);
          const f32x4 bb0 = *(const LAS f32x4*)(Bb + c * BP + sub * 8), bb1 = *(const LAS f32x4*)(Bb + c * BP + sub * 8 + 4);
          const f32x4 tf0 = *(const LAS f32x4*)(Bf + 63 * BP + sub * 8), tf1 = *(const LAS f32x4*)(Bf + 63 * BP + sub * 8 + 4);
          const f32x4 tb0 = *(const LAS f32x4*)(Bb + sub * 8), tb1 = *(const LAS f32x4*)(Bb + sub * 8 + 4);
#pragma unroll
          for (int i = 0; i < 8; ++i) { const int dk = sub * 8 + i; const float kf = bf2f((unsigned short)kk[i]);
              const float bfv = i < 4 ? bf0[i & 3] : bf1[i & 3], bbv = i < 4 ? bb0[i & 3] : bb1[i & 3], tfv = i < 4 ? tf0[i & 3] : tf1[i & 3], tbv = i < 4 ? tb0[i & 3] : tb1[i & 3];
              keT0[dk * LP + c] = (bf16_t)f2bf(kf * __expf(tfv - bfv));
              keT1[dk * LP + c] = (bf16_t)f2bf(kf * __expf(tbv - bbv)); }
#pragma unroll
          for (int i = 0; i < 8; ++i) { vT[(sub * 16 + i) * LP + c] = (bf16_t)v0[i]; vT[(sub * 16 + 8 + i) * LP + c] = (bf16_t)v1[i]; } }
        if (tid < 128) { const int d = tid >> 6, dk = tid & 63; DEC[(size_t)(it * 2 + d) * 64 + dk] = __expf(d == 0 ? Bf[63 * BP + dk] : Bb[dk]); }
        LBAR();
        { const int e0 = wave * 16;
          bf16x8 bv[2];
#pragma unroll
          for (int ks = 0; ks < 2; ++ks) bv[ks] = *(const LAS bf16x8*)(vT + (e0 + fr) * LP + ks * 32 + fq * 8);
#pragma unroll
          for (int d = 0; d < 2; ++d) { const LAS bf16_t* ke = d == 0 ? keT0 : keT1; bf16_t* dst = KV + (size_t)(it * 2 + d) * 8192 + (size_t)(e0 + fr) * 64;
#pragma unroll
              for (int dt = 0; dt < 4; ++dt) { f32x4 acc = {0.f, 0.f, 0.f, 0.f};
#pragma unroll
                  for (int ks = 0; ks < 2; ++ks) { const bf16x8 a = *(const LAS bf16x8*)(ke + (dt * 16 + fr) * LP + ks * 32 + fq * 8); acc = __builtin_amdgcn_mfma_f32_16x16x32_bf16(a, bv[ks], acc, 0, 0, 0); }
                  u32x2 w; w.x = pk2(acc[0], acc[1]); w.y = pk2(acc[2], acc[3]); *(u32x2*)(dst + dt * 16 + fq * 4) = w; } } }
        LBAR();
        gc = gn; kk = nkk; v0 = nv0; v1 = nv1;
    }
    bf16_t* P = (bf16_t*)(p.ws + WS_P);
    LAS float* cs = (LAS float*)lds; constexpr int CSP = 132;
    for (int pit = blockIdx.x; pit < NB * 128 * 4; pit += G) {
        const int pq = pit >> 8, pc = pit & 255, gi = (pc + pq) & 3, pidx = pq * 64 + (pc >> 2), Rr = pidx & 127, b = pidx >> 7, half = 1 << gi;
        const int rlo = max(Rr - half, 0), rhi = min(Rr + half, 128);
        const int col = tid >> 3, ch0 = (tid & 7) * 16;
        const bf16_t* basep = PA + (size_t)(b * SEQ) * PAW + PA_P + gi * 128 + ch0;
        float acc[16], uc[16];
        if (gi == 0) pool_vertical<1>(basep, Rr, col, acc, uc); else if (gi == 1) pool_vertical<2>(basep, Rr, col, acc, uc);
        else if (gi == 2) pool_vertical<4>(basep, Rr, col, acc, uc); else pool_vertical<8>(basep, Rr, col, acc, uc);
#pragma unroll
        for (int i = 0; i < 4; ++i) *(LAS f32x4*)(cs + col * CSP + ch0 + 4 * i) = (f32x4){acc[4 * i], acc[4 * i + 1], acc[4 * i + 2], acc[4 * i + 3]};
        LBAR();
        const int clo = max(col - half, 0), chi = min(col + half, 64);
        f32x4 sum[4];
#pragma unroll
        for (int i = 0; i < 4; ++i) sum[i] = (f32x4){0.f, 0.f, 0.f, 0.f};
        for (int cc = clo; cc < chi; ++cc) {
#pragma unroll
            for (int i = 0; i < 4; ++i) sum[i] = sum[i] + *(const LAS f32x4*)(cs + cc * CSP + ch0 + 4 * i); }
        const float inv = 1.f / (float)((rhi - rlo) * (chi - clo));
        bf16_t* op = P + (size_t)(b * SEQ + Rr * 64 + col) * 512 + gi * 128 + ch0;
        u32x4 w0, w1;
        w0.x = pk2(sum[0][0] * inv - uc[0], sum[0][1] * inv - uc[1]); w0.y = pk2(sum[0][2] * inv - uc[2], sum[0][3] * inv - uc[3]);
        w0.z = pk2(sum[1][0] * inv - uc[4], sum[1][1] * inv - uc[5]); w0.w = pk2(sum[1][2] * inv - uc[6], sum[1][3] * inv - uc[7]);
        w1.x = pk2(sum[2][0] * inv - uc[8], sum[2][1] * inv - uc[9]); w1.y = pk2(sum[2][2] * inv - uc[10], sum[2][3] * inv - uc[11]);
        w1.z = pk2(sum[3][0] * inv - uc[12], sum[3][1] * inv - uc[13]); w1.w = pk2(sum[3][2] * inv - uc[14], sum[3][3] * inv - uc[15]);
        *(u32x4*)op = w0; *(u32x4*)(op + 8) = w1;
        LBAR();
    }
    for (int idx = (int)blockIdx.x * 512 + tid; idx < RC * 32; idx += G * 512) {
        const int tok = idx >> 5, ch0 = (idx & 31) * 16, gi = ch0 >> 7, half = 1 << gi, b = tok >> 8, t = tok & 255;
        const int lo = max(t - half, 0), hi = min(t + half, CTXL);
        const bf16_t* basep = PA + (size_t)(RL + b * CTXL) * PAW + PA_P + ch0;
        float acc[16], uc[16];
#pragma unroll
        for (int i = 0; i < 16; ++i) { acc[i] = 0.f; uc[i] = 0.f; }
        for (int tt = lo; tt < hi; ++tt) { const bf16_t* pp = basep + (size_t)tt * PAW; const bf16x8 a0 = *(const bf16x8*)pp, a1 = *(const bf16x8*)(pp + 8);
            const bool ctr = (tt == t);
#pragma unroll
            for (int i = 0; i < 8; ++i) { const float f0 = bf2f((unsigned short)a0[i]), f1 = bf2f((unsigned short)a1[i]); acc[i] += f0; acc[8 + i] += f1; if (ctr) { uc[i] = f0; uc[8 + i] = f1; } } }
        const float inv = 1.f / (float)(hi - lo);
        bf16_t* op = P + (size_t)(RL + tok) * 512 + ch0;
        u32x4 w0, w1;
        w0.x = pk2(acc[0] * inv - uc[0], acc[1] * inv - uc[1]); w0.y = pk2(acc[2] * inv - uc[2], acc[3] * inv - uc[3]);
        w0.z = pk2(acc[4] * inv - uc[4], acc[5] * inv - uc[5]); w0.w = pk2(acc[6] * inv - uc[6], acc[7] * inv - uc[7]);
        w1.x = pk2(acc[8] * inv - uc[8], acc[9] * inv - uc[9]); w1.y = pk2(acc[10] * inv - uc[10], acc[11] * inv - uc[11]);
        w1.z = pk2(acc[12] * inv - uc[12], acc[13] * inv - uc[13]); w1.w = pk2(acc[14] * inv - uc[14], acc[15] * inv - uc[15]);
        *(u32x4*)op = w0; *(u32x4*)(op + 8) = w1;
    }
}

__device__ __forceinline__ int scan_item(int step, int b, int h, int d) {
    int cgi;
    if (step < 4) cgi = 256 + b * 4 + (d == 0 ? step : 3 - step);
    else cgi = b * 128 + (d == 0 ? step - 4 : 127 - (step - 4));
    return (cgi * 4 + h) * 2 + d;
}
__device__ __forceinline__ void gla_scan_phase(const Params& p) {
    bf16_t* KV = (bf16_t*)(p.ws + WS_KV); const float* DEC = (const float*)(p.ws + WS_DEC);
    for (int idx = (int)blockIdx.x * 512 + otid(); idx < 16 * 8192; idx += (int)gridDim.x * 512) {
        const int sid = idx >> 13, el = idx & 8191, dk = el & 63, d = sid & 1, h = (sid >> 1) & 3, b = sid >> 3;
        float s = 0.f;
        { float kv[4], dc[4]; int item[4];
#pragma unroll
          for (int i = 0; i < 4; ++i) { item[i] = scan_item(i, b, h, d); kv[i] = bf2f(KV[(size_t)item[i] * 8192 + el]); dc[i] = DEC[(size_t)item[i] * 64 + dk]; }
#pragma unroll
          for (int i = 0; i < 4; ++i) { KV[(size_t)item[i] * 8192 + el] = (bf16_t)f2bf(s); s = s * dc[i] + kv[i]; } }
        for (int s0 = 4; s0 < 132; s0 += 32) { float kv[32], dc[32]; int item[32];
#pragma unroll
          for (int i = 0; i < 32; ++i) { item[i] = scan_item(s0 + i, b, h, d); kv[i] = bf2f(KV[(size_t)item[i] * 8192 + el]); dc[i] = DEC[(size_t)item[i] * 64 + dk]; }
#pragma unroll
          for (int i = 0; i < 32; ++i) { KV[(size_t)item[i] * 8192 + el] = (bf16_t)f2bf(s); s = s * dc[i] + kv[i]; } }
    }
}

__device__ __forceinline__ void gla_out_phase(const Params& p, int l, LAS unsigned char* lds, int nitems) {
    const int tid = otid(), lane = tid & 63, wave = tid >> 6, fr = lane & 15, fq = lane >> 4, G = gridDim.x;
    LAS float* Bf = (LAS float*)lds; LAS float* Bb = (LAS float*)(lds + 17408);
    LAS bf16_t* qt0 = (LAS bf16_t*)(lds + 34816); LAS bf16_t* qt1 = (LAS bf16_t*)(lds + 34816 + 9216);
    LAS bf16_t* kt0 = (LAS bf16_t*)(lds + 34816 + 2 * 9216); LAS bf16_t* kt1 = (LAS bf16_t*)(lds + 34816 + 3 * 9216);
    LAS bf16_t* vT = (LAS bf16_t*)(lds + 34816 + 4 * 9216);
    LAS bf16_t* attw = (LAS bf16_t*)(lds + 34816 + 4 * 9216 + 18432) + wave * (16 * LP);
    LAS float* red = (LAS float*)(lds + 34816 + 4 * 9216 + 18432 + 8 * 16 * LP * 2);
    const bf16_t* PA = (const bf16_t*)(p.ws + WS_PA); const bf16_t* KV = (const bf16_t*)(p.ws + WS_KV); bf16_t* GO = (bf16_t*)(p.ws + WS_H);
    const float* gnw = p.gla_norm_w + l * 128;
    const int ct = wave & 3, eh = wave >> 2, c = tid & 63, sub = tid >> 6;
    GateIn gc; bf16x8 qq = {0, 0, 0, 0, 0, 0, 0, 0}, kk = qq, v0 = qq, v1 = qq;
    int it = blockIdx.x;
    if (it < nitems) { gates_load(p, l, it, lane, wave, gc); const bf16_t* rowp = PA + (size_t)((it >> 2) * 64 + c) * PAW; const int h = it & 3;
        qq = *(const bf16x8*)(rowp + PA_Q + h * 64 + sub * 8); kk = *(const bf16x8*)(rowp + PA_K + h * 64 + sub * 8);
        v0 = *(const bf16x8*)(rowp + PA_V + h * 128 + sub * 16); v1 = *(const bf16x8*)(rowp + PA_V + h * 128 + sub * 16 + 8); }
    for (; it < nitems; it += G) {
        const int h = it & 3, r0 = (it >> 2) * 64;
        bf16x8 bs[2][4][2];
#pragma unroll
        for (int d = 0; d < 2; ++d)
#pragma unroll
            for (int et = 0; et < 4; ++et)
#pragma unroll
                for (int ks = 0; ks < 2; ++ks) bs[d][et][ks] = *(const bf16x8*)(KV + (size_t)(it * 2 + d) * 8192 + (size_t)(eh * 64 + et * 16 + fr) * 64 + ks * 32 + fq * 8);
        const int nit = it + G; GateIn gn = gc; bf16x8 nqq = qq, nkk = kk, nv0 = v0, nv1 = v1;
        if (nit < nitems) { gates_load(p, l, nit, lane, wave, gn); const bf16_t* rowp = PA + (size_t)((nit >> 2) * 64 + c) * PAW; const int nh = nit & 3;
            nqq = *(const bf16x8*)(rowp + PA_Q + nh * 64 + sub * 8); nkk = *(const bf16x8*)(rowp + PA_K + nh * 64 + sub * 8);
            nv0 = *(const bf16x8*)(rowp + PA_V + nh * 128 + sub * 16); nv1 = *(const bf16x8*)(rowp + PA_V + nh * 128 + sub * 16 + 8); }
        gates_compute(gc, lane, wave, Bf, Bb);
        LBAR();
        { const f32x4 bf0 = *(const LAS f32x4*)(Bf + c * BP + sub * 8), bf1 = *(const LAS f32x4*)(Bf + c * BP + sub * 8 + 4);
          const f32x4 bb0 = *(const LAS f32x4*)(Bb + c * BP + sub * 8), bb1 = *(const LAS f32x4*)(Bb + c * BP + sub * 8 + 4);
          u32x4 w;
          { float qf[8], qb[8];
#pragma unroll
            for (int i = 0; i < 8; ++i) { const float q = bf2f((unsigned short)qq[i]); const float bf = i < 4 ? bf0[i & 3] : bf1[i & 3], bb = i < 4 ? bb0[i & 3] : bb1[i & 3]; qf[i] = q * __expf(bf); qb[i] = q * __expf(bb); }
            w.x = pk2(qf[0], qf[1]); w.y = pk2(qf[2], qf[3]); w.z = pk2(qf[4], qf[5]); w.w = pk2(qf[6], qf[7]); *(LAS u32x4*)(qt0 + c * LP + sub * 8) = w;
            w.x = pk2(qb[0], qb[1]); w.y = pk2(qb[2], qb[3]); w.z = pk2(qb[4], qb[5]); w.w = pk2(qb[6], qb[7]); *(LAS u32x4*)(qt1 + c * LP + sub * 8) = w; }
          { float kf[8], kb[8];
#pragma unroll
            for (int i = 0; i < 8; ++i) { const float k = bf2f((unsigned short)kk[i]); const float bf = i < 4 ? bf0[i & 3] : bf1[i & 3], bb = i < 4 ? bb0[i & 3] : bb1[i & 3]; kf[i] = k * __expf(-bf); kb[i] = k * __expf(-bb); }
            w.x = pk2(kf[0], kf[1]); w.y = pk2(kf[2], kf[3]); w.z = pk2(kf[4], kf[5]); w.w = pk2(kf[6], kf[7]); *(LAS u32x4*)(kt0 + c * LP + sub * 8) = w;
            w.x = pk2(kb[0], kb[1]); w.y = pk2(kb[2], kb[3]); w.z = pk2(kb[4], kb[5]); w.w = pk2(kb[6], kb[7]); *(LAS u32x4*)(kt1 + c * LP + sub * 8) = w; }
#pragma unroll
          for (int i = 0; i < 8; ++i) { vT[(sub * 16 + i) * LP + c] = (bf16_t)v0[i]; vT[(sub * 16 + 8 + i) * LP + c] = (bf16_t)v1[i]; } }
        LBAR();
        unsigned short rg[4][4];
#pragma unroll
        for (int j = 0; j < 4; ++j)
#pragma unroll
            for (int et = 0; et < 4; ++et) rg[j][et] = PA[(size_t)(r0 + ct * 16 + fq * 4 + j) * PAW + PA_R + h * 128 + eh * 64 + et * 16 + fr];
        f32x4 acco[4];
#pragma unroll
        for (int et = 0; et < 4; ++et) acco[et] = (f32x4){0.f, 0.f, 0.f, 0.f};
#pragma unroll
        for (int d = 0; d < 2; ++d) {
            const LAS bf16_t* qt = d == 0 ? qt0 : qt1; const LAS bf16_t* kt = d == 0 ? kt0 : kt1;
            bf16x8 aq[2];
#pragma unroll
            for (int ks = 0; ks < 2; ++ks) aq[ks] = *(const LAS bf16x8*)(qt + (ct * 16 + fr) * LP + ks * 32 + fq * 8);
#pragma unroll
            for (int mt = 0; mt < 4; ++mt) { f32x4 sacc = {0.f, 0.f, 0.f, 0.f};
#pragma unroll
                for (int ks = 0; ks < 2; ++ks) { const bf16x8 bk = *(const LAS bf16x8*)(kt + (mt * 16 + fr) * LP + ks * 32 + fq * 8); sacc = __builtin_amdgcn_mfma_f32_16x16x32_bf16(aq[ks], bk, sacc, 0, 0, 0); }
                const int mm = mt * 16 + fr;
#pragma unroll
                for (int j = 0; j < 4; ++j) { const int cc = ct * 16 + fq * 4 + j; const bool keep = d == 0 ? (mm <= cc) : (mm > cc);
                    attw[(fq * 4 + j) * LP + mm] = (bf16_t)f2bf(keep ? sacc[j] : 0.f); } }
            LWAIT();
            bf16x8 aa[2];
#pragma unroll
            for (int ks = 0; ks < 2; ++ks) aa[ks] = *(const LAS bf16x8*)(attw + fr * LP + ks * 32 + fq * 8);
#pragma unroll
            for (int et = 0; et < 4; ++et) { const int e = eh * 64 + et * 16 + fr;
#pragma unroll
                for (int ks = 0; ks < 2; ++ks) { const bf16x8 bv = *(const LAS bf16x8*)(vT + e * LP + ks * 32 + fq * 8); acco[et] = __builtin_amdgcn_mfma_f32_16x16x32_bf16(aa[ks], bv, acco[et], 0, 0, 0); }
#pragma unroll
                for (int ks = 0; ks < 2; ++ks) acco[et] = __builtin_amdgcn_mfma_f32_16x16x32_bf16(aq[ks], bs[d][et][ks], acco[et], 0, 0, 0); }
            LWAIT();
        }
        float ss[4];
#pragma unroll
        for (int j = 0; j < 4; ++j) { float t = 0.f;
#pragma unroll
            for (int et = 0; et < 4; ++et) t += acco[et][j] * acco[et][j];
            t += __shfl_xor(t, 1); t += __shfl_xor(t, 2); t += __shfl_xor(t, 4); t += __shfl_xor(t, 8); ss[j] = t; }
        if (fr == 0) {
#pragma unroll
            for (int j = 0; j < 4; ++j) red[eh * 64 + ct * 16 + fq * 4 + j] = ss[j]; }
        LBAR();
#pragma unroll
        for (int j = 0; j < 4; ++j) { const int cc = ct * 16 + fq * 4 + j; const float rstd = rsqrtf((red[cc] + red[64 + cc]) * (1.f / 128.f) + 1e-6f);
            bf16_t* orow = GO + (size_t)(r0 + cc) * 512 + h * 128;
#pragma unroll
            for (int et = 0; et < 4; ++et) { const int e = eh * 64 + et * 16 + fr;
                orow[e] = (bf16_t)f2bf(acco[et][j] * rstd * gnw[e] * siluf_(bf2f(rg[j][et]))); } }
        LBAR();
        gc = gn; qq = nqq; kk = nkk; v0 = nv0; v1 = nv1;
    }
}

#define XB_TMO      128
#define XB_XCNT(j)  (256  + 64 * (j))
#define XB_XSUB(j)  (1280 + 64 * (j))
#define XB_XGEN(j)  (2304 + 64 * (j))
#define XB_TOP      3328
#define XB_TOPGEN   3392
#define XCD_BAR_WORDS 3456
#define XB_SPIN_CAP (1u << 18)

__device__ __forceinline__ unsigned xb_ld(unsigned* p)              { return __hip_atomic_load(p, __ATOMIC_RELAXED, __HIP_MEMORY_SCOPE_AGENT); }
__device__ __forceinline__ unsigned xb_add(unsigned* p, unsigned v) { return __hip_atomic_fetch_add(p, v, __ATOMIC_RELAXED, __HIP_MEMORY_SCOPE_AGENT); }
__device__ __forceinline__ unsigned xb_xcc_id() { return (unsigned)__builtin_amdgcn_s_getreg((3 << 11) | 20) & 0xFu; }
#define XB_SPIN(cond, bar) do { unsigned _sp = 0; while (cond) { __builtin_amdgcn_s_sleep(1); \
    if ((++_sp & 255u) == 0u) { if (xb_ld(&(bar)[XB_TMO])) break; if (_sp > XB_SPIN_CAP) { atomicAdd(&(bar)[XB_TMO], 1u); break; } } } } while (0)

#define RLX_AGENT __ATOMIC_RELAXED, __HIP_MEMORY_SCOPE_AGENT
struct XcdBarrier {
    unsigned* bar; unsigned x;
    volatile LAS unsigned* st;
};

__device__ __forceinline__ XcdBarrier xcd_barrier_post(unsigned* bar, volatile LAS unsigned* st) {
    XcdBarrier b; b.bar = bar; b.x = xb_xcc_id(); b.st = st;
    if (threadIdx.x == 0) (void)xb_add(&bar[XB_XCNT(b.x)], 1u);
    return b;
}
__device__ __forceinline__ void xcd_barrier_complete(unsigned* bar, unsigned x, unsigned& nloc, unsigned& nx) {
    const unsigned G = gridDim.x * gridDim.y * gridDim.z;
    unsigned sum, cnt, mine, sp = 0u;
    for (;;) {
        sum = 0u; cnt = 0u; mine = 0u;
#pragma unroll
        for (unsigned j = 0; j < 16; ++j) { const unsigned c = xb_ld(&bar[XB_XCNT(j)]); sum += c; cnt += (c > 0u) ? 1u : 0u; mine = (j == x) ? c : mine; }
        if (sum == G) break;
        __builtin_amdgcn_s_sleep(1);
        if ((++sp & 255u) == 0u) { if (xb_ld(&bar[XB_TMO])) break; if (sp > XB_SPIN_CAP) { atomicAdd(&bar[XB_TMO], 1u); break; } }
    }
    nloc = mine > 0u ? mine : 1u; nx = cnt > 0u ? cnt : 1u;
}

__device__ __forceinline__ void xcd_barrier(const XcdBarrier& b) {
    asm volatile("s_waitcnt vmcnt(0)" ::: "memory");
    __syncthreads();
    if (threadIdx.x == 0) {
        unsigned* bar = b.bar;
        __builtin_amdgcn_s_waitcnt(0);
        unsigned nloc = b.st[0], nx = b.st[1];
        if (nloc == 0u) { xcd_barrier_complete(bar, b.x, nloc, nx); b.st[0] = nloc; b.st[1] = nx; }
        const unsigned old = xb_add(&bar[XB_XSUB(b.x)], 1u);
        const unsigned gen = old / nloc;
        if (old + 1u == (gen + 1u) * nloc) {
            __builtin_amdgcn_fence(__ATOMIC_RELEASE, "agent");
            asm volatile("s_waitcnt vmcnt(0)" ::: "memory");
            const unsigned og = xb_add(&bar[XB_TOP], 1u);
            const unsigned tg = og / nx;
            if (og + 1u == (tg + 1u) * nx) xb_add(&bar[XB_TOPGEN], 1u);
            else XB_SPIN(xb_ld(&bar[XB_TOPGEN]) == tg, bar);
            __builtin_amdgcn_fence(__ATOMIC_ACQUIRE, "agent");
            xb_add(&bar[XB_XGEN(b.x)], 1u);
            asm volatile("s_waitcnt vmcnt(0)" ::: "memory");
        } else {
            XB_SPIN(xb_ld(&bar[XB_XGEN(b.x)]) == gen, bar);
            __builtin_amdgcn_fence(__ATOMIC_ACQUIRE, "agent");
            asm volatile("s_waitcnt vmcnt(0)" ::: "memory");
        }
    }
    __syncthreads();
}
constexpr int NPHASE = 2 + DEPTH * 14;
constexpr size_t WS_BAR = (WS_END + 255) & ~(size_t)255;
constexpr size_t WS_FCNT = WS_BAR + XCD_BAR_WORDS * 4;
constexpr size_t WS_TOTAL = WS_FCNT + 64 * 256;
constexpr int LDS_BARST = 131072;
#ifndef FUSE_A
#define FUSE_A 1
#endif
#ifndef FUSE_B
#define FUSE_B 1
#endif
#ifndef PROBE_MASK
#define PROBE_MASK 0
#endif
__global__ void __launch_bounds__(512, 2) fwd_megakernel(Params p_karg) {
    extern __shared__ __attribute__((aligned(16))) unsigned char lds_raw[];
    LAS unsigned char* lds = (LAS unsigned char*)lds_raw;
    cg::grid_group grid = cg::this_grid();
    if (threadIdx.x < 4) ((volatile LAS unsigned*)(lds + LDS_BARST))[threadIdx.x] = 0u;
    __syncthreads();
    if (blockIdx.x == 0) { unsigned* z = (unsigned*)(p_karg.ws + WS_BAR); for (int i = (int)threadIdx.x; i < XCD_BAR_WORDS + 64 * 64; i += 512) z[i] = 0u; }
    XcdBarrier bar; bar.bar = (unsigned*)(p_karg.ws + WS_BAR); bar.x = xb_xcc_id(); bar.st = (volatile LAS unsigned*)(lds + LDS_BARST);
    int xrank = 0;
    int vblk = (int)blockIdx.x;
    for (int ph = 0; ph < NPHASE; ++ph) {
        int id = ph == 0 ? 0 : (ph == NPHASE - 1 ? 15 : 1 + (ph - 1) % 14), l = ph == 0 ? 0 : (ph == NPHASE - 1 ? 0 : (ph - 1) / 14);
        asm volatile("" : "+s"(id), "+s"(l));
        const __attribute__((address_space(4))) Params* kp = (const __attribute__((address_space(4))) Params*)__builtin_amdgcn_kernarg_segment_ptr();
        asm volatile("" : "+s"(kp));
        const Params& p = *(const Params*)kp;
      for (int rep = 0; rep < 2; ++rep) {
        unsigned char* ws = p.ws;
        bf16_t* H = (bf16_t*)(ws + WS_H); bf16_t* ACT = (bf16_t*)(ws + WS_PA); bf16_t* PA = (bf16_t*)(ws + WS_PA); bf16_t* PG = (bf16_t*)(ws + WS_PG);
        bf16_t* MG = (bf16_t*)(ws + WS_PA); bf16_t* P = (bf16_t*)(ws + WS_P); bf16_t* GO = (bf16_t*)(ws + WS_H);
        float* xc = (float*)(ws + WS_CX); float* SP = (float*)(ws + WS_SP); float* SQ = (float*)(ws + WS_SQ) + (size_t)l * 3 * RL; const float* BIASL = (const float*)(ws + WS_BIAS) + (size_t)l * BIAS_L; const float* MOD = (const float*)(ws + WS_MOD);
        const unsigned char* wl = ws + WS_W + (size_t)l * WL_SIZE; const float* modl = MOD + (size_t)l * 3 * NMOD;
        const bool lastl = (l == DEPTH - 1); const bool fastfinal = ((int)gridDim.x == 256);
        switch (id) {
            case 0: phase0(p, lds); break;
            case 1: norm_phase(p, l, 0, l > 0 ? 11 : 0, R, l == 0 ? p.x : p.out, l == 0 ? p.ctx : xc, (FUSE_A && l > 0) ? 1 : 0); if (l == 0) bias_phase(p); break;
            case 2: run_gemm(lds, vblk, H, (const bf16_t*)(wl + WL_UP1), 2 * DFF, D, 1, EpiSwiGLU{ACT, (FUSE_A && l > 0) ? SQ : nullptr, BIASL + B_UP1}); break;
            case 3: run_gemm(lds, vblk, ACT, (const bf16_t*)(wl + WL_DN1), D, DFF, 11, EpiResid{p.out, l == 0 ? p.x : p.out, modl + 2 * D, SP, FUSE_B ? H : nullptr, p.norm_w + (size_t)(l * 3 + 1) * D, modl + 4 * D, SQ + RL, 0.5f}); break;
            case 4: norm_phase(p, l, 1, 11, R, p.out, l == 0 ? p.ctx : xc, FUSE_B); break;
            case 5: run_gemm(lds, vblk, H, (const bf16_t*)(wl + WL_WIN), 4096, D, 1, EpiProj{PA, PG, FUSE_B ? SQ + RL : nullptr, BIASL + B_WIN}); lowrank_phase(p, l, vblk, FUSE_B ? SQ + RL : nullptr, BIASL + B_LR); break;
            case 6: gla_kv_phase(p, l, lds); break;
            case 7: gla_scan_phase(p); break;
            case 8: gla_out_phase(p, l, lds, l == DEPTH - 1 ? NGI - 32 : NGI); break;
            case 9: run_gemm(lds, vblk, P, (const bf16_t*)(wl + WL_WPT), D, 512, lastl ? 0 : 1, EpiBranch{MG, PG, 0, 0}); break;
            case 10: run_gemm(lds, vblk, GO, (const bf16_t*)(wl + WL_WGT), D, 512, lastl ? 0 : 1, EpiBranch{MG, PG, 1024, 1}); break;
            case 11: run_gemm(lds, vblk, MG, (const bf16_t*)(wl + WL_WOT), D, D, lastl ? 0 : 4, EpiResid{p.out, p.out, modl + 5 * D, SP, FUSE_A ? H : nullptr, p.norm_w + (size_t)(l * 3 + 2) * D, modl + 7 * D, SQ + 2 * RL, 1.0f}); break;
            case 12: norm_phase(p, l, 2, 4, lastl ? RL : R, p.out, xc, FUSE_A); break;
            case 13: run_gemm(lds, vblk, H, (const bf16_t*)(wl + WL_UP2), 2 * DFF, D, lastl ? 0 : 1, EpiSwiGLU{ACT, FUSE_A ? SQ + 2 * RL : nullptr, BIASL + B_UP2}); break;
            case 14: if (lastl && fastfinal) run_gemm(lds, vblk, ACT, (const bf16_t*)(wl + WL_DN2), D, DFF, 0, EpiFinal{p.out, p.out, modl + 8 * D, p.final_norm_w, (float*)(ws + WS_XCH), (unsigned*)(ws + WS_FCNT), 0.5f});
                else run_gemm(lds, vblk, ACT, (const bf16_t*)(wl + WL_DN2), D, DFF, lastl ? 0 : 11, EpiResid{p.out, p.out, modl + 8 * D, SP, (FUSE_A && !lastl) ? H : nullptr, p.norm_w + (size_t)((l + 1) * 3) * D, modl + 3 * NMOD + D, SQ + 3 * RL, 0.5f}); break;
            default: if (!fastfinal) final_norm(p); break;
        }
        if (!((PROBE_MASK >> id) & 1)) break;
      }
        if (ph == 0) {
            grid.sync();
            if (threadIdx.x == 0) ((volatile LAS unsigned*)(lds + LDS_BARST))[2] = xb_add(&bar.bar[XB_XCNT(bar.x)], 1u);
            __syncthreads();
            xrank = __builtin_amdgcn_readfirstlane((int)((volatile LAS unsigned*)(lds + LDS_BARST))[2]);
        } else if (ph != NPHASE - 1 && id != 9 && !(FUSE_A && id == 12 && l == DEPTH - 1) && !((int)gridDim.x == 256 && id == 14 && l == DEPTH - 1)) xcd_barrier(bar);
        if (ph == 1) {
            bool ok = (gridDim.x == 256);
#pragma unroll
            for (unsigned j = 0; j < 16; ++j) { const unsigned cnt = xb_ld(&bar.bar[XB_XCNT(j)]); ok = ok && (cnt == (j < 8 ? 32u : 0u)); }
            vblk = ok ? xrank * 8 + (int)bar.x : (int)blockIdx.x;
            vblk = __builtin_amdgcn_readfirstlane(vblk);
        }
    }
}

extern "C" void kernel_launch(void* const* d_in, const int* in_sizes, int n_in, void* d_out, int out_size, void* d_ws, size_t ws_size, hipStream_t stream) {
    static int grid_blocks = 0;
    if (grid_blocks == 0) {
        if (n_in != 23 || out_size != RL * D || ws_size < WS_TOTAL) { fprintf(stderr, "kernel_launch: unexpected sizes (n_in %d out %d ws %zu need %zu)\n", n_in, out_size, ws_size, (size_t)WS_TOTAL); grid_blocks = -1; return; }
        int dev = 0, cus = 0, per_cu = 0;
        if (hipGetDevice(&dev) != hipSuccess || hipDeviceGetAttribute(&cus, hipDeviceAttributeMultiprocessorCount, dev) != hipSuccess) { grid_blocks = -1; return; }
        if (hipFuncSetAttribute((const void*)fwd_megakernel, hipFuncAttributeMaxDynamicSharedMemorySize, LDS_BYTES) != hipSuccess) { fprintf(stderr, "kernel_launch: hipFuncSetAttribute failed\n"); grid_blocks = -1; return; }
        if (hipOccupancyMaxActiveBlocksPerMultiprocessor(&per_cu, (const void*)fwd_megakernel, 512, LDS_BYTES) != hipSuccess || per_cu < 1) { fprintf(stderr, "kernel_launch: occupancy query failed (%d)\n", per_cu); grid_blocks = -1; return; }
        grid_blocks = cus * per_cu;
    }
    if (grid_blocks < 0) return;
    Params p{};
    const float** pp = (const float**)&p;
    for (int i = 0; i < 23; ++i) pp[i] = (const float*)d_in[i];
    p.out = (float*)d_out; p.ws = (unsigned char*)d_ws;
    void* args[] = {&p};
    hipError_t e = hipLaunchCooperativeKernel((const void*)fwd_megakernel, dim3(grid_blocks), dim3(512), args, LDS_BYTES, stream);
    if (e != hipSuccess) fprintf(stderr, "cooperative launch failed: %s (grid %d)\n", hipGetErrorString(e), grid_blocks);
}
```

```cpp
#include <hip/hip_runtime.h>
#include <hip/hip_cooperative_groups.h>
#include <cstdio>
namespace cg = cooperative_groups;
__device__ __forceinline__ int otid() { int t = (int)threadIdx.x; asm volatile("" : "+v"(t)); return t; }
namespace pg8 {
#define PG8_LAS __attribute__((address_space(3)))
typedef unsigned short bf16_t;
typedef short bf16x8 __attribute__((ext_vector_type(8)));
typedef float f32x4 __attribute__((ext_vector_type(4)));
typedef unsigned u32x4 __attribute__((ext_vector_type(4)));
constexpr int BM = 256, BK = 64, HALF = 128, HTB = HALF * BK * 2  , STAGE_BYTES = 8 * HTB, NXCD = 8, WGM = 8;

__host__ __device__ __forceinline__ int lds_byte(int r, int c) { const int st = (r >> 4) * 2 + (c >> 5), rr = r & 15, cc = c & 31, ob = rr * 64 + cc * 2; return st * 1024 + (ob ^ (((ob >> 9) & 1) << 5)); }
__host__ __device__ __forceinline__ void stage_rc(int b, int& R, int& C) { const int st = b / 1024, sb = b % 1024, swz = sb ^ (((sb >> 9) & 1) << 5); R = (st >> 1) * 16 + swz / 64; C = (st & 1) * 32 + (swz % 64) / 2; }
__host__ __device__ __forceinline__ int perm32(int rho) { const int n = rho >> 4, i = rho & 15; return 8 * (i >> 2) + 4 * n + (i & 3); }

struct Unit { int pm, pn, kt0, nkt; };
struct Gemm { const bf16_t* A; const bf16_t* Bt; int M, N, K; };

struct StaticOrder {
    int nM, nN, nwg, G, c, nkt_full;
    __host__ __device__ void init(int M, int N, int G_, int c_) { nM = M / BM; nN = N / BM; nwg = nM * nN; G = G_; c = c_; }
    __host__ __device__ bool next(int i, Unit& u) const {
        const long L = (long)i * G + c; if (L >= nwg) return false;
        int wgid = (int)L; { const int q = nwg / NXCD, r = nwg % NXCD, xcd = wgid % NXCD, off = wgid / NXCD; wgid = (xcd < r ? xcd * (q + 1) : r * (q + 1) + (xcd - r) * q) + off; }
        const int nig = WGM * nN, gid = wgid / nig, fm = gid * WGM, gsz = (nM - fm) < WGM ? (nM - fm) : WGM;
        u.pm = fm + ((wgid % nig) % gsz); u.pn = (wgid % nig) / gsz; u.kt0 = 0; u.nkt = nkt_full; return true;
    }
    __device__ __forceinline__ void a_ready(const Unit&) const {}
    __device__ __forceinline__ void done(const Unit&) const {}
};
__device__ __forceinline__ unsigned cvt_pk_bf16(float lo, float hi) { unsigned r; asm volatile("v_cvt_pk_bf16_f32 %0, %1, %2" : "=v"(r) : "v"(lo), "v"(hi)); return r; }
typedef float f32x2 __attribute__((ext_vector_type(2)));

template <class Epi, class Sched, bool STAMP = false>
__device__ __forceinline__ void gemm_phase(PG8_LAS unsigned char* lds, const Gemm g, const Sched& S, const Epi& E, unsigned long long* stamps) {
    const int tid = otid(), wid = __builtin_amdgcn_readfirstlane(tid >> 6), lane = tid & 63, wr = wid >> 2, wc = wid & 3, fr = lane & 15, fq = lane >> 4;
    const int K = g.K;
    int ts_lo = 0, ts_hi = 0, nts = 0; const unsigned long long rt_entry = STAMP ? (unsigned long long)wall_clock64() : 0ull;
#define PG8_STAMP() do { if (STAMP && wid == 0 && nts < 64) { const unsigned long long _c = (unsigned long long)clock64(); \
        ts_lo = (lane == nts) ? (int)(unsigned)_c : ts_lo; ts_hi = (lane == nts) ? (int)(unsigned)(_c >> 32) : ts_hi; ++nts; } } while (0)
    PG8_STAMP();
    unsigned voffA[2], voffB[2];
#pragma unroll
    for (int i = 0; i < 2; ++i) { int R, C; stage_rc(tid * 16 + i * 8192, R, C); const int Rb = Epi::PERM ? ((R & ~31) + perm32(R & 31)) : R;
        voffA[i] = (unsigned)(R * K + C) * 2u; voffB[i] = (unsigned)(Rb * K + C) * 2u; }
    const size_t kstep = (size_t)(BK * 2);
    const size_t hstep = (size_t)HALF * K * 2;
    const size_t tstep = 2 * hstep;
    const unsigned ldsw = (unsigned)wid * 1024u;
    const int aoff = lds_byte(wr * 64 + fr, fq * 8), boff = lds_byte(wc * 32 + fr, fq * 8);
#define PG8_SA(b, h) (((b) * 2 + (h)) * HTB)
#define PG8_SB(b, h) ((4 + (b) * 2 + (h)) * HTB)
#define PG8_STAGE(bufoff, gbase, voff) do { _Pragma("unroll") for (int _i = 0; _i < 2; ++_i) \
        __builtin_amdgcn_global_load_lds((const unsigned*)((const char*)(gbase) + (voff)[_i]), (PG8_LAS unsigned*)(lds + (bufoff) + ldsw + _i * 8192), 16, 0, 0); } while (0)
#define PG8_LDA(dst, b, h) do { _Pragma("unroll") for (int m = 0; m < 4; ++m) _Pragma("unroll") for (int k = 0; k < 2; ++k) dst[m][k] = *(const PG8_LAS bf16x8*)(lds + PG8_SA(b, h) + aoff + m * 2048 + k * 1024); } while (0)
#define PG8_LDB(dst, b, h) do { _Pragma("unroll") for (int n = 0; n < 2; ++n) _Pragma("unroll") for (int k = 0; k < 2; ++k) dst[n][k] = *(const PG8_LAS bf16x8*)(lds + PG8_SB(b, h) + boff + n * 2048 + k * 1024); } while (0)
#define PG8_MMA(ai, bj, At, Bt) do { __builtin_amdgcn_s_setprio(1); _Pragma("unroll") for (int m = 0; m < 4; ++m) _Pragma("unroll") for (int n = 0; n < 2; ++n) _Pragma("unroll") for (int k = 0; k < 2; ++k) \
        acc[ai][bj][m][n] = __builtin_amdgcn_mfma_f32_16x16x32_bf16(Bt[n][k], At[m][k], acc[ai][bj][m][n], 0, 0, 0); __builtin_amdgcn_s_setprio(0); } while (0)
#define PG8_WAIT_V(n) asm volatile("s_waitcnt vmcnt(" #n ")" ::: "memory")
#define PG8_WAIT_L(n) asm volatile("s_waitcnt lgkmcnt(" #n ")" ::: "memory")
#define PG8_BAR __builtin_amdgcn_s_barrier()
#define PG8_SCHED __builtin_amdgcn_sched_barrier(0)
    Unit cur, nxt; int ui = 0;
    if (!S.next(0, cur)) return;
    f32x4 acc[2][2][4][2];
    float pf[Epi::NPF > 0 ? Epi::NPF : 1];
#pragma unroll
    for (int a = 0; a < 2; ++a)
#pragma unroll
        for (int b = 0; b < 2; ++b)
#pragma unroll
            for (int m = 0; m < 4; ++m)
#pragma unroll
                for (int n = 0; n < 2; ++n) acc[a][b][m][n] = (f32x4){0.f, 0.f, 0.f, 0.f};
    bf16x8 At[4][2], B0[2][2], B1[2][2];
    const char* cA = (const char*)g.A + (size_t)cur.pm * tstep + (size_t)cur.kt0 * kstep; const char* cB = (const char*)g.Bt + (size_t)cur.pn * tstep + (size_t)cur.kt0 * kstep;
    S.a_ready(cur);
    PG8_STAGE(PG8_SB(0, 0), cB, voffB); PG8_STAGE(PG8_SA(0, 0), cA, voffA); PG8_STAGE(PG8_SB(0, 1), cB + hstep, voffB); PG8_STAGE(PG8_SA(0, 1), cA + hstep, voffA);
    if (wr == 1) PG8_BAR;
    PG8_WAIT_V(4); PG8_BAR;
    PG8_STAGE(PG8_SB(1, 0), cB + kstep, voffB); PG8_STAGE(PG8_SA(1, 0), cA + kstep, voffA); PG8_STAGE(PG8_SB(1, 1), cB + hstep + kstep, voffB);
    PG8_WAIT_V(6); PG8_BAR;
    PG8_STAMP();
    for (;;) {
        const bool has_next = S.next(ui + 1, nxt);
        const char* nA = has_next ? (const char*)g.A + (size_t)nxt.pm * tstep + (size_t)nxt.kt0 * kstep : cA; const char* nB = has_next ? (const char*)g.Bt + (size_t)nxt.pn * tstep + (size_t)nxt.kt0 * kstep : cB;
        const int nt = cur.nkt;
        for (int t = 0; t < nt; t += 2) {
            const bool last = (t == nt - 2);
            const char* a1 = cA + (size_t)(t + 1) * kstep;
            const char* a2 = last ? nA : cA + (size_t)(t + 2) * kstep; const char* b2 = last ? nB : cB + (size_t)(t + 2) * kstep;
            const char* a3 = a2 + kstep; const char* b3 = b2 + kstep;
            if (last && has_next) S.a_ready(nxt);
            if constexpr (Epi::NPF > 0) { if (last) E.prefetch(cur, wr, wc, fr, fq, pf); }
            PG8_LDB(B0, 0, 0); PG8_SCHED; PG8_LDA(At, 0, 0); PG8_STAGE(PG8_SA(1, 1), a1 + hstep, voffA);
            PG8_WAIT_L(8); PG8_BAR; PG8_WAIT_L(0); PG8_MMA(0, 0, At, B0); PG8_BAR; PG8_SCHED;
            PG8_LDB(B1, 0, 1); PG8_STAGE(PG8_SB(0, 0), b2, voffB);
            PG8_BAR; PG8_WAIT_L(0); PG8_MMA(0, 1, At, B1); PG8_BAR;
            PG8_LDA(At, 0, 1); PG8_STAGE(PG8_SA(0, 0), a2, voffA);
            PG8_BAR; PG8_WAIT_L(0); PG8_MMA(1, 0, At, B0); PG8_BAR; PG8_SCHED;
            PG8_STAGE(PG8_SB(0, 1), b2 + hstep, voffB);
            PG8_WAIT_V(6); PG8_BAR; PG8_MMA(1, 1, At, B1); PG8_BAR;
            PG8_LDB(B0, 1, 0); PG8_SCHED; PG8_LDA(At, 1, 0); PG8_STAGE(PG8_SA(0, 1), a2 + hstep, voffA);
            PG8_WAIT_L(8); PG8_BAR; PG8_WAIT_L(0); PG8_MMA(0, 0, At, B0); PG8_BAR; PG8_SCHED;
            PG8_LDB(B1, 1, 1); PG8_STAGE(PG8_SB(1, 0), b3, voffB);
            PG8_BAR; PG8_WAIT_L(0); PG8_MMA(0, 1, At, B1); PG8_BAR;
            PG8_LDA(At, 1, 1); PG8_STAGE(PG8_SA(1, 0), a3, voffA);
            PG8_BAR; PG8_WAIT_L(0); PG8_MMA(1, 0, At, B0); PG8_BAR; PG8_SCHED;
            PG8_STAGE(PG8_SB(1, 1), b3 + hstep, voffB);
            PG8_WAIT_V(6); PG8_BAR; PG8_MMA(1, 1, At, B1); PG8_BAR;
        }
        PG8_STAMP();
        if constexpr (!Epi::AFTER_DRAIN) { if constexpr (Epi::NPF > 0) E(acc, cur, wr, wc, fr, fq, pf); else E(acc, cur, wr, wc, fr, fq); S.done(cur); }
        PG8_STAMP();
        if (!has_next) break;
#pragma unroll
        for (int a = 0; a < 2; ++a)
#pragma unroll
            for (int b = 0; b < 2; ++b)
#pragma unroll
                for (int m = 0; m < 4; ++m)
#pragma unroll
                    for (int n = 0; n < 2; ++n) acc[a][b][m][n] = (f32x4){0.f, 0.f, 0.f, 0.f};
        cur = nxt; cA = nA; cB = nB; ++ui;
    }
    PG8_WAIT_V(0);
    if (wr == 0) PG8_BAR;
    PG8_BAR;
    if constexpr (Epi::AFTER_DRAIN) { E.fused(acc, cur, wr, wc, fr, fq, lds, wid, lane); S.done(cur); }
    PG8_STAMP();
    if (STAMP && wid == 0) { stamps[lane] = lane < nts ? (((unsigned long long)(unsigned)ts_hi << 32) | (unsigned)ts_lo) : 0ull;
        if (lane == 62) stamps[62] = rt_entry; if (lane == 63) stamps[63] = (unsigned long long)wall_clock64(); }
#undef PG8_STAMP
#undef PG8_SA
#undef PG8_SB
#undef PG8_STAGE
#undef PG8_LDA
#undef PG8_LDB
#undef PG8_MMA
#undef PG8_WAIT_V
#undef PG8_WAIT_L
#undef PG8_BAR
#undef PG8_SCHED
}
}

#define LAS __attribute__((address_space(3)))
typedef unsigned short bf16_t;
typedef short bf16x8 __attribute__((ext_vector_type(8)));
typedef float f32x4 __attribute__((ext_vector_type(4)));
typedef unsigned u32x4 __attribute__((ext_vector_type(4)));
typedef unsigned u32x2 __attribute__((ext_vector_type(2)));

constexpr int D = 1024, SEQ = 8192, NB = 2, CTXL = 256, DFF = 2816, DEPTH = 2;
constexpr int RL = NB * SEQ;
constexpr int RC = NB * CTXL;
constexpr int R = RL + RC;
constexpr int INC = 4128;
constexpr int OFF_K = 0, OFF_V = 256, OFF_AF = 768, OFF_Q = 800, OFF_R = 1056, OFF_POOL = 1568, OFF_GP = 2080, OFF_GG = 3104;
constexpr int PA_K = 0, PA_V = 256, PA_Q = 768, PA_R = 1024, PA_P = 1536, PAW = 2048;
constexpr int NCHUNK = R / 64;
constexpr int NITEM = NCHUNK * 4 * 2;
constexpr int NMOD = 9 * D;

constexpr size_t WL_UP1 = 0, WL_DN1 = 11534336, WL_WIN = 17301504, WL_LRT = 25690112, WL_WPT = 25755648, WL_WGT = 26804224,
                 WL_WOT = 27852800, WL_UP2 = 29949952, WL_DN2 = 41484288, WL_SIZE = 47251456;
constexpr size_t WS_W = 0;
constexpr size_t WS_H = WS_W + 2 * WL_SIZE;
constexpr size_t WS_PA = WS_H + (size_t)R * 1024 * 2;
constexpr size_t WS_PG = WS_PA + (size_t)R * 2048 * 2;
constexpr size_t WS_KV = WS_PG + (size_t)R * 2048 * 2;
constexpr size_t WS_P = WS_KV + (size_t)NITEM * 8192 * 2;
constexpr size_t WS_LR = WS_P + (size_t)R * 512 * 2;
constexpr size_t WS_CX = WS_LR + (size_t)R * 32 * 4;
constexpr size_t WS_MOD = WS_CX + (size_t)RC * 1024 * 4;
constexpr size_t WS_DEC = WS_MOD + (size_t)DEPTH * 3 * NMOD * 4;
constexpr size_t WS_SQ = WS_DEC + (size_t)NITEM * 64 * 4;
constexpr size_t WS_BIAS = WS_SQ + (size_t)6 * RL * 4;
constexpr int B_UP1 = 0, B_WIN = 2 * 5632, B_LR = B_WIN + 2 * 4096, B_UP2 = B_LR + 2 * 32, BIAS_L = B_UP2 + 2 * 5632;
constexpr size_t WS_XCH = WS_BIAS + (size_t)DEPTH * BIAS_L * 4;
constexpr size_t WS_END = WS_XCH + (size_t)64 * 4 * 256 * 4;
constexpr size_t WS_SP = WS_PA + (size_t)R * 2816 * 2;
static_assert(WS_SP + (size_t)11 * RC * 1024 * 4 <= WS_KV, "split-K scratch fits");
constexpr int LDS_BYTES = 147456;

struct Params {
    const float *x, *c, *ctx, *c_ctx, *w_mod, *b_mod, *norm_w, *ffn1_up, *ffn1_down, *w_in, *w_af_up, *b_af, *w_ab_up, *b_ab,
                *gla_norm_w, *pool_w, *pool_scale, *w_br_pool, *w_br_gla, *w_out, *ffn2_up, *ffn2_down, *final_norm_w;
    float* out; unsigned char* ws;
};

typedef __bf16 bf16x2_t __attribute__((ext_vector_type(2)));
__device__ __forceinline__ unsigned pk2(float lo, float hi) { bf16x2_t v = {(__bf16)lo, (__bf16)hi}; return __builtin_bit_cast(unsigned, v); }
__device__ __forceinline__ unsigned f2bf(float f) { return (unsigned)__builtin_bit_cast(unsigned short, (__bf16)f); }
__device__ __forceinline__ float bf2f(unsigned short b) { return __builtin_bit_cast(float, ((unsigned)b) << 16); }
__device__ __forceinline__ float bflo(unsigned w) { return __builtin_bit_cast(float, w << 16); }
__device__ __forceinline__ float bfhi(unsigned w) { return __builtin_bit_cast(float, w & 0xffff0000u); }
__device__ __forceinline__ float sigmoidf_(float v) { return __builtin_amdgcn_rcpf(1.f + __builtin_amdgcn_exp2f(-1.44269504f * v)); }
__device__ __forceinline__ float siluf_(float v) { return v * __builtin_amdgcn_rcpf(1.f + __builtin_amdgcn_exp2f(-1.44269504f * v)); }
__device__ __forceinline__ float log_sigmoidf_(float v) { return fminf(v, 0.f) - log1pf(__expf(-fabsf(v))); }
__device__ __forceinline__ float wave_sum(float v) {
#pragma unroll
    for (int o = 1; o < 64; o <<= 1) v += __shfl_xor(v, o);
    return v;
}
__device__ __forceinline__ int mod_index(int r) { return r < SEQ ? 0 : (r < RL ? 1 : 2); }
__device__ __forceinline__ float* xrow_ptr(float* xl, float* xc, int r) { return r < RL ? xl + (size_t)r * D : xc + (size_t)(r - RL) * D; }

struct EpiSwiGLU {
    static constexpr bool PERM = true, AFTER_DRAIN = false;
    bf16_t* O; const float* sq; const float* bias;
    static constexpr int NPF = 16;
    __device__ __forceinline__ void prefetch(const pg8::Unit u, int wr, int wc, int fr, int fq, float (&pf)[16]) const {
        const bool fz = (sq != nullptr) && (u.pm < 64); const int row0 = u.pm * 256 + wr * 64 + fr;
#pragma unroll
        for (int i = 0; i < 8; ++i) pf[i] = fz ? sq[row0 + (i >> 2) * 128 + (i & 3) * 16] : 0.f;
        const float* bp = bias + (u.pm >= 32 ? 2 * DFF : 0) + u.pn * 256 + wc * 32 + 8 * fq;
#pragma unroll
        for (int bj = 0; bj < 2; ++bj) { const f32x4 a = fz ? *(const f32x4*)(bp + bj * 128) : (f32x4){0.f, 0.f, 0.f, 0.f}, b = fz ? *(const f32x4*)(bp + bj * 128 + 4) : (f32x4){0.f, 0.f, 0.f, 0.f};
            pf[8 + bj * 4 + 0] = __builtin_bit_cast(float, pk2(a[0], a[1])); pf[8 + bj * 4 + 1] = __builtin_bit_cast(float, pk2(a[2], a[3]));
            pf[8 + bj * 4 + 2] = __builtin_bit_cast(float, pk2(b[0], b[1])); pf[8 + bj * 4 + 3] = __builtin_bit_cast(float, pk2(b[2], b[3])); }
    }
    __device__ __forceinline__ void operator()(const f32x4 (&acc)[2][2][4][2], const pg8::Unit u, int wr, int wc, int fr, int fq, const float (&pf)[16]) const {
        const int row0 = u.pm * 256 + wr * 64 + fr, col0 = u.pn * 128 + wc * 16 + 4 * fq;
        const bool fz = (sq != nullptr) && (u.pm < 64);
        f32x4 ba[2], bb[2];
#pragma unroll
        for (int bj = 0; bj < 2; ++bj) { const unsigned w0 = __builtin_bit_cast(unsigned, pf[8 + bj * 4]), w1 = __builtin_bit_cast(unsigned, pf[9 + bj * 4]), w2 = __builtin_bit_cast(unsigned, pf[10 + bj * 4]), w3 = __builtin_bit_cast(unsigned, pf[11 + bj * 4]);
            ba[bj] = (f32x4){bflo(w0), bfhi(w0), bflo(w1), bfhi(w1)}; bb[bj] = (f32x4){bflo(w2), bfhi(w2), bflo(w3), bfhi(w3)}; }
#pragma unroll
        for (int ai = 0; ai < 2; ++ai)
#pragma unroll
            for (int m = 0; m < 4; ++m) { const int r = row0 + ai * 128 + m * 16; bf16_t* rowp = O + (size_t)r * DFF + col0;
                const float rstd = fz ? rsqrtf(pf[ai * 4 + m] * (1.f / D) + 1e-6f) : 1.f;
#pragma unroll
                for (int bj = 0; bj < 2; ++bj) { const f32x4 a = acc[ai][bj][m][0] * rstd + ba[bj], b = acc[ai][bj][m][1] * rstd + bb[bj];
                    u32x2 w; w.x = pk2(siluf_(a[0]) * b[0], siluf_(a[1]) * b[1]); w.y = pk2(siluf_(a[2]) * b[2], siluf_(a[3]) * b[3]);
                    *(u32x2*)(rowp + bj * 64) = w; } }
    }
};
struct EpiResid { static constexpr int NPF = 0;
    static constexpr bool PERM = false, AFTER_DRAIN = false;
    float* xl; const float* xin; const float* gate; float* sp; bf16_t* Hn; const float* nwn; const float* scn; float* sqn; float coef;
    __device__ __forceinline__ void operator()(const f32x4 (&acc)[2][2][4][2], const pg8::Unit u, int wr, int wc, int fr, int fq) const {
        const int row0 = u.pm * 256 + wr * 64 + fr, col0 = u.pn * 256 + wc * 32 + 4 * fq;
        const bool fz = (Hn != nullptr) && (u.pm < 64);
        const bool ctxu = (u.pm >= 64);
        const int mi = u.pm < 32 ? 0 : (u.pm < 64 ? 1 : 2);
        f32x4 gc[2][2], wm[2][2];
#pragma unroll
        for (int bj = 0; bj < 2; ++bj)
#pragma unroll
            for (int n = 0; n < 2; ++n) { const int off = col0 + bj * 128 + n * 16; gc[bj][n] = *(const f32x4*)(gate + (size_t)mi * NMOD + off) * coef;
                wm[bj][n] = fz ? *(const f32x4*)(nwn + off) * (*(const f32x4*)(scn + (size_t)mi * NMOD + off) + 1.f) : (f32x4){0.f, 0.f, 0.f, 0.f}; }
#pragma unroll
        for (int ai = 0; ai < 2; ++ai)
#pragma unroll
            for (int mh = 0; mh < 2; ++mh) {
                f32x4 xv[2][2][2];
#pragma unroll
                for (int mm = 0; mm < 2; ++mm)
#pragma unroll
                    for (int bj = 0; bj < 2; ++bj)
#pragma unroll
                        for (int n = 0; n < 2; ++n) xv[mm][bj][n] = ctxu ? (f32x4){0.f, 0.f, 0.f, 0.f} : *(const f32x4*)(xin + (size_t)(row0 + ai * 128 + (mh * 2 + mm) * 16) * D + col0 + bj * 128 + n * 16);
#pragma unroll
                for (int mm = 0; mm < 2; ++mm) { const int m = mh * 2 + mm; const int r = row0 + ai * 128 + m * 16; float* rowp = xl + (size_t)r * D + col0;
                    float ss = 0.f;
#pragma unroll
                    for (int bj = 0; bj < 2; ++bj)
#pragma unroll
                        for (int n = 0; n < 2; ++n) { const int off = bj * 128 + n * 16; const f32x4 dv = gc[bj][n] * acc[ai][bj][m][n];
                            if (ctxu) { *(f32x4*)(sp + ((size_t)(u.kt0 / u.nkt) * RC + (r - RL)) * D + col0 + off) = dv; }
                            else { const f32x4 x = xv[mm][bj][n] + dv; *(f32x4*)(rowp + off) = x;
                                if (fz) { const f32x4 xw = x * wm[bj][n]; u32x2 o; o.x = pk2(xw[0], xw[1]); o.y = pk2(xw[2], xw[3]); *(u32x2*)(Hn + (size_t)r * D + col0 + off) = o;
                                    ss += (x[0] * x[0] + x[1] * x[1]) + (x[2] * x[2] + x[3] * x[3]); } } }
                    if (fz) { ss += __shfl_xor(ss, 16); ss += __shfl_xor(ss, 32); if (fq == 0) unsafeAtomicAdd(sqn + r, ss); } } }
    }
};
struct EpiFinal { static constexpr int NPF = 0;
    static constexpr bool PERM = false, AFTER_DRAIN = true;
    float* out; const float* xin; const float* gate; const float* fw; float* xch; unsigned* cnt; float coef;
    __device__ __forceinline__ void fused(const f32x4 (&acc)[2][2][4][2], const pg8::Unit u, int wr, int wc, int fr, int fq, LAS unsigned char* lds, int wid, int lane) const {
        const int row0 = u.pm * 256 + wr * 64 + fr, col0 = u.pn * 256 + wc * 32 + 4 * fq, tid = wid * 64 + lane;
        const int mi = u.pm < 32 ? 0 : 1;
        LAS float* T = (LAS float*)lds; LAS float* RS = (LAS float*)(lds + 4096);
        f32x4 gc[2][2];
#pragma unroll
        for (int bj = 0; bj < 2; ++bj)
#pragma unroll
            for (int n = 0; n < 2; ++n) gc[bj][n] = *(const f32x4*)(gate + (size_t)mi * NMOD + col0 + bj * 128 + n * 16) * coef;
        f32x4 xn[2][2][4][2];
#pragma unroll
        for (int ai = 0; ai < 2; ++ai)
#pragma unroll
            for (int mh = 0; mh < 2; ++mh) {
                f32x4 xv[2][2][2];
#pragma unroll
                for (int mm = 0; mm < 2; ++mm)
#pragma unroll
                    for (int bj = 0; bj < 2; ++bj)
#pragma unroll
                        for (int n = 0; n < 2; ++n) xv[mm][bj][n] = *(const f32x4*)(xin + (size_t)(row0 + ai * 128 + (mh * 2 + mm) * 16) * D + col0 + bj * 128 + n * 16);
#pragma unroll
                for (int mm = 0; mm < 2; ++mm) { const int m = mh * 2 + mm; float ss = 0.f;
#pragma unroll
                    for (int bj = 0; bj < 2; ++bj)
#pragma unroll
                        for (int n = 0; n < 2; ++n) { const f32x4 x = xv[mm][bj][n] + gc[bj][n] * acc[ai][bj][m][n]; xn[ai][bj][m][n] = x; ss += (x[0] * x[0] + x[1] * x[1]) + (x[2] * x[2] + x[3] * x[3]); }
                    ss += __shfl_xor(ss, 16); ss += __shfl_xor(ss, 32);
                    if (fq == 0) T[(ai * 128 + wr * 64 + m * 16 + fr) * 4 + wc] = ss; } }
        __syncthreads();
        float* slot = xch + (size_t)(u.pm * 4 + u.pn) * 256;
        if (tid < 256) { const float t = (T[tid * 4 + 0] + T[tid * 4 + 1]) + (T[tid * 4 + 2] + T[tid * 4 + 3]); __hip_atomic_store(slot + tid, t, __ATOMIC_RELAXED, __HIP_MEMORY_SCOPE_AGENT); }
        asm volatile("s_waitcnt vmcnt(0)" ::: "memory");
        __syncthreads();
        if (tid == 0) { __hip_atomic_fetch_add(cnt + u.pm * 64, 1u, __ATOMIC_RELAXED, __HIP_MEMORY_SCOPE_AGENT);
            unsigned polls = 0; while (__hip_atomic_load(cnt + u.pm * 64, __ATOMIC_RELAXED, __HIP_MEMORY_SCOPE_AGENT) < 4u) { if (++polls > (1u << 20)) break; __builtin_amdgcn_s_sleep(1); }
            __builtin_amdgcn_fence(__ATOMIC_ACQUIRE, "agent"); asm volatile("s_waitcnt vmcnt(0)" ::: "memory"); }
        __syncthreads();
        if (tid < 256) { const float* base = xch + (size_t)(u.pm * 4) * 256 + tid; float t = 0.f;
#pragma unroll
            for (int q = 0; q < 4; ++q) t += __hip_atomic_load(base + q * 256, __ATOMIC_RELAXED, __HIP_MEMORY_SCOPE_AGENT);
            RS[tid] = rsqrtf(t * (1.f / D) + 1e-6f); }
        __syncthreads();
        f32x4 w4[2][2];
#pragma unroll
        for (int bj = 0; bj < 2; ++bj)
#pragma unroll
            for (int n = 0; n < 2; ++n) w4[bj][n] = *(const f32x4*)(fw + col0 + bj * 128 + n * 16);
#pragma unroll
        for (int ai = 0; ai < 2; ++ai)
#pragma unroll
            for (int m = 0; m < 4; ++m) { const float rstd = RS[ai * 128 + wr * 64 + m * 16 + fr]; float* rowp = out + (size_t)(row0 + ai * 128 + m * 16) * D + col0;
#pragma unroll
                for (int bj = 0; bj < 2; ++bj)
#pragma unroll
                    for (int n = 0; n < 2; ++n) *(f32x4*)(rowp + bj * 128 + n * 16) = (xn[ai][bj][m][n] * rstd) * w4[bj][n]; }
    }
};
struct EpiProj {
    static constexpr bool PERM = true, AFTER_DRAIN = false;
    bf16_t* O0; bf16_t* O1; const float* sq; const float* bias;
    static constexpr int NPF = 16;
    __device__ __forceinline__ void prefetch(const pg8::Unit u, int wr, int wc, int fr, int fq, float (&pf)[16]) const {
        const bool fz = (sq != nullptr) && (u.pm < 64); const int row0 = u.pm * 256 + wr * 64 + fr;
#pragma unroll
        for (int i = 0; i < 8; ++i) pf[i] = fz ? sq[row0 + (i >> 2) * 128 + (i & 3) * 16] : 0.f;
        const float* bp = bias + (u.pm >= 32 ? 4096 : 0) + u.pn * 256 + wc * 32 + 8 * fq;
#pragma unroll
        for (int bj = 0; bj < 2; ++bj) { const f32x4 a = fz ? *(const f32x4*)(bp + bj * 128) : (f32x4){0.f, 0.f, 0.f, 0.f}, b = fz ? *(const f32x4*)(bp + bj * 128 + 4) : (f32x4){0.f, 0.f, 0.f, 0.f};
            pf[8 + bj * 4 + 0] = __builtin_bit_cast(float, pk2(a[0], a[1])); pf[8 + bj * 4 + 1] = __builtin_bit_cast(float, pk2(a[2], a[3]));
            pf[8 + bj * 4 + 2] = __builtin_bit_cast(float, pk2(b[0], b[1])); pf[8 + bj * 4 + 3] = __builtin_bit_cast(float, pk2(b[2], b[3])); }
    }
    __device__ __forceinline__ void operator()(const f32x4 (&acc)[2][2][4][2], const pg8::Unit u, int wr, int wc, int fr, int fq, const float (&pf)[16]) const {
        const int row0 = u.pm * 256 + wr * 64 + fr; int colt = u.pn * 256; bf16_t* base = O0; if (colt >= 2048) { base = O1; colt -= 2048; }
        const int col0 = colt + wc * 32 + 8 * fq;
        const bool fz = (sq != nullptr) && (u.pm < 64);
        f32x4 b0[2], b1[2];
#pragma unroll
        for (int bj = 0; bj < 2; ++bj) { const unsigned w0 = __builtin_bit_cast(unsigned, pf[8 + bj * 4]), w1 = __builtin_bit_cast(unsigned, pf[9 + bj * 4]), w2 = __builtin_bit_cast(unsigned, pf[10 + bj * 4]), w3 = __builtin_bit_cast(unsigned, pf[11 + bj * 4]);
            b0[bj] = (f32x4){bflo(w0), bfhi(w0), bflo(w1), bfhi(w1)}; b1[bj] = (f32x4){bflo(w2), bfhi(w2), bflo(w3), bfhi(w3)}; }
#pragma unroll
        for (int ai = 0; ai < 2; ++ai)
#pragma unroll
            for (int m = 0; m < 4; ++m) { const int r = row0 + ai * 128 + m * 16; bf16_t* rowp = base + (size_t)r * PAW + col0;
                const float rstd = fz ? rsqrtf(pf[ai * 4 + m] * (1.f / D) + 1e-6f) : 1.f;
#pragma unroll
                for (int bj = 0; bj < 2; ++bj) { const f32x4 v0 = acc[ai][bj][m][0] * rstd + b0[bj], v1 = acc[ai][bj][m][1] * rstd + b1[bj];
                    u32x4 w; w.x = pk2(v0[0], v0[1]); w.y = pk2(v0[2], v0[3]); w.z = pk2(v1[0], v1[1]); w.w = pk2(v1[2], v1[3]);
                    *(u32x4*)(rowp + bj * 128) = w; } }
    }
};
struct EpiBranch { static constexpr int NPF = 0;
    static constexpr bool PERM = true, AFTER_DRAIN = false;
    bf16_t* MG; const bf16_t* PG; int goff; int accum;
    __device__ __forceinline__ void operator()(const f32x4 (&acc)[2][2][4][2], const pg8::Unit u, int wr, int wc, int fr, int fq) const {
        const int row0 = u.pm * 256 + wr * 64 + fr, col0 = u.pn * 256 + wc * 32 + 8 * fq;
#pragma unroll
        for (int ai = 0; ai < 2; ++ai)
#pragma unroll
          for (int mh = 0; mh < 2; ++mh) {
            u32x4 gv[2][2], ov[2][2];
#pragma unroll
            for (int mm = 0; mm < 2; ++mm)
#pragma unroll
                for (int bj = 0; bj < 2; ++bj) { const int r = row0 + ai * 128 + (mh * 2 + mm) * 16; gv[mm][bj] = *(const u32x4*)(PG + (size_t)r * PAW + goff + col0 + bj * 128);
                    ov[mm][bj] = accum ? *(const u32x4*)(MG + (size_t)r * 1024 + col0 + bj * 128) : (u32x4){0u, 0u, 0u, 0u}; }
#pragma unroll
            for (int mm = 0; mm < 2; ++mm) { const int m = mh * 2 + mm; const int r = row0 + ai * 128 + m * 16; bf16_t* rowp = MG + (size_t)r * 1024 + col0;
#pragma unroll
                for (int bj = 0; bj < 2; ++bj) { const f32x4 v0 = acc[ai][bj][m][0], v1 = acc[ai][bj][m][1];
                    const u32x4 g = gv[mm][bj], old = ov[mm][bj];
                    float o[8];
                    o[0] = sigmoidf_(bflo(g.x)) * v0[0]; o[1] = sigmoidf_(bfhi(g.x)) * v0[1]; o[2] = sigmoidf_(bflo(g.y)) * v0[2]; o[3] = sigmoidf_(bfhi(g.y)) * v0[3];
                    o[4] = sigmoidf_(bflo(g.z)) * v1[0]; o[5] = sigmoidf_(bfhi(g.z)) * v1[1]; o[6] = sigmoidf_(bflo(g.w)) * v1[2]; o[7] = sigmoidf_(bfhi(g.w)) * v1[3];
                    if (accum) { o[0] += bflo(old.x); o[1] += bfhi(old.x); o[2] += bflo(old.y); o[3] += bfhi(old.y); o[4] += bflo(old.z); o[5] += bfhi(old.z); o[6] += bflo(old.w); o[7] += bfhi(old.w); }
                    u32x4 w; w.x = pk2(o[0], o[1]); w.y = pk2(o[2], o[3]); w.z = pk2(o[4], o[5]); w.w = pk2(o[6], o[7]);
                    *(u32x4*)(rowp + bj * 128) = w; } } }
    }
};

struct CtxSplitOrder {
    pg8::StaticOrder M; int ksplit, nctx, nkt_part;
    __device__ void init(int N, int K, int G, int c, int ks) { M.init(RL, N, G, c); M.nkt_full = K / 64; ksplit = ks > 0 ? ks : 1; nctx = 2 * M.nN * ks; nkt_part = (K / 64) / ksplit; }
    __device__ bool next(int i, pg8::Unit& u) const {
        const long L = (long)i * M.G + M.c;
        if (L < M.nwg) return M.next(i, u);
        const int j = (int)(L - M.nwg); if (j >= nctx) return false;
        const int kp = j % ksplit, t = j / ksplit; u.pn = t % M.nN; u.pm = 64 + t / M.nN; u.kt0 = kp * nkt_part; u.nkt = nkt_part; return true;
    }
    __device__ __forceinline__ void a_ready(const pg8::Unit&) const {}
    __device__ __forceinline__ void done(const pg8::Unit&) const {}
};
template <class Epi>
__device__ __forceinline__ void run_gemm(LAS unsigned char* lds, int vblk, const bf16_t* A, const bf16_t* Bt, int N, int K, int ksplit, const Epi& E) {
    pg8::Gemm g{A, Bt, R, N, K}; CtxSplitOrder S; S.init(N, K, (int)gridDim.x, vblk, ksplit);
    pg8::gemm_phase<Epi, CtxSplitOrder, false>(lds, g, S, E, nullptr);
}

__device__ __forceinline__ int src_col(int kind, int n, float& sc) {
    sc = 1.f;
    if (kind == 0) return n;
    if (kind == 1) { const int q = n >> 3, e = n & 7; return e < 4 ? 4 * q + e : DFF + 4 * q + (e - 4); }
    if (kind == 2) { if (n < 256) return OFF_K + n; if (n < 768) return OFF_V + (n - 256); if (n < 1024) { sc = 0.125f; return OFF_Q + (n - 768); }
        if (n < 1536) return OFF_R + (n - 1024); if (n < 2048) return OFF_POOL + (n - 1536); if (n < 3072) return OFF_GP + (n - 2048); return OFF_GG + (n - 3072); }
    return OFF_AF + n;
}
__device__ __forceinline__ void tconv_job(const float* __restrict__ src, int ld, int K, int N, bf16_t* dst, int kind, LAS float* tile, int& base) {
    const int tid = otid(), G = gridDim.x;
    const int nnb = (N + 63) / 64, nt = (K / 64) * nnb;
    const int first = (((int)blockIdx.x - base) % G + G) % G;
    for (int t = first; t < nt; t += G) {
        const int k0 = (t / nnb) * 64, n0 = (t % nnb) * 64;
        { const int j = tid & 63, i0 = tid >> 6; float sc = 1.f; const bool ok = (n0 + j) < N; const int col = ok ? src_col(kind, n0 + j, sc) : 0;
#pragma unroll
          for (int i = 0; i < 8; ++i) { const int kk = i0 + 8 * i; tile[kk * 65 + j] = ok ? src[(size_t)(k0 + kk) * ld + col] * sc : 0.f; } }
        __syncthreads();
        { const int n = tid >> 3, ch = tid & 7; const LAS float* s = tile + (8 * ch) * 65 + n;
          if (n0 + n < N) { u32x4 o; o.x = pk2(s[0], s[65]); o.y = pk2(s[130], s[195]); o.z = pk2(s[260], s[325]); o.w = pk2(s[390], s[455]);
              *(u32x4*)(dst + (size_t)(n0 + n) * K + k0 + 8 * ch) = o; } }
        __syncthreads();
    }
    base += nt;
}

__device__ __forceinline__ void phase0(const Params& p, LAS unsigned char* lds) {
    const int tid = otid(), lane = tid & 63, wave = tid >> 6, G = gridDim.x;
    LAS float* tile = (LAS float*)lds;
    LAS float* scond = (LAS float*)(lds + 20480);
    LAS float* red = (LAS float*)(lds + 20480 + 12288);
    unsigned char* ws = p.ws;
    int base = 0;
    for (int l = 0; l < DEPTH; ++l) {
        unsigned char* wl = ws + WS_W + (size_t)l * WL_SIZE;
        tconv_job(p.ffn1_up + (size_t)l * D * 2 * DFF, 2 * DFF, D, 2 * DFF, (bf16_t*)(wl + WL_UP1), 1, tile, base);
        tconv_job(p.ffn1_down + (size_t)l * DFF * D, D, DFF, D, (bf16_t*)(wl + WL_DN1), 0, tile, base);
        tconv_job(p.w_in + (size_t)l * D * INC, INC, D, 4096, (bf16_t*)(wl + WL_WIN), 2, tile, base);
        tconv_job(p.w_in + (size_t)l * D * INC, INC, D, 32, (bf16_t*)(wl + WL_LRT), 3, tile, base);
        tconv_job(p.w_br_gla + (size_t)l * 512 * D, D, 512, D, (bf16_t*)(wl + WL_WGT), 0, tile, base);
        tconv_job(p.w_out + (size_t)l * D * D, D, D, D, (bf16_t*)(wl + WL_WOT), 0, tile, base);
        tconv_job(p.ffn2_up + (size_t)l * D * 2 * DFF, 2 * DFF, D, 2 * DFF, (bf16_t*)(wl + WL_UP2), 1, tile, base);
        tconv_job(p.ffn2_down + (size_t)l * DFF * D, D, DFF, D, (bf16_t*)(wl + WL_DN2), 0, tile, base);
    }
    const int gt = (int)blockIdx.x * 512 + tid, NT = G * 512;
    for (int idx = gt; idx < DEPTH * 512 * 256; idx += NT) {
        const int n4 = idx & 255, k = (idx >> 8) & 511, l = idx >> 17, g = k >> 7, kl = k & 127;
        const float* pw = p.pool_w + ((size_t)(l * 4 + g) * 128 + kl) * 128; const float* ps = p.pool_scale + l * 512 + g * 128;
        const float* wb = p.w_br_pool + ((size_t)l * 512 + g * 128) * D + n4 * 4;
        f32x4 a = {0.f, 0.f, 0.f, 0.f};
#pragma unroll 4
        for (int j = 0; j < 128; ++j) { const float s = pw[j] * ps[j]; a = a + *(const f32x4*)(wb + (size_t)j * D) * s; }
        bf16_t* d = (bf16_t*)(ws + WS_W + (size_t)l * WL_SIZE + WL_WPT) + (size_t)(n4 * 4) * 512 + k;
        d[0] = (bf16_t)f2bf(a[0]); d[512] = (bf16_t)f2bf(a[1]); d[1024] = (bf16_t)f2bf(a[2]); d[1536] = (bf16_t)f2bf(a[3]);
    }
    { float* sq = (float*)(ws + WS_SQ); for (int i = gt; i < 6 * RL; i += NT) sq[i] = 0.f; }
    for (int i = tid; i < 3 * D; i += 512) { const int mi = i >> 10, kk = i & 1023; const float v = mi < 2 ? p.c[mi * D + kk] : p.c_ctx[kk]; scond[i] = siluf_(v); }
    __syncthreads();
    float* MOD = (float*)(ws + WS_MOD);
    for (int it = G - 1 - (int)blockIdx.x; it < DEPTH * 144; it += G) {
        const int l = it / 144, n0 = (it % 144) * 64; const float* wm = p.w_mod + (size_t)l * D * NMOD + n0 + lane;
        float a0 = 0.f, a1 = 0.f, a2 = 0.f;
#pragma unroll 8
        for (int kk = wave; kk < D; kk += 8) { const float w = wm[(size_t)kk * NMOD]; a0 += scond[kk] * w; a1 += scond[D + kk] * w; a2 += scond[2 * D + kk] * w; }
        red[(wave * 3 + 0) * 64 + lane] = a0; red[(wave * 3 + 1) * 64 + lane] = a1; red[(wave * 3 + 2) * 64 + lane] = a2;
        __syncthreads();
        if (tid < 192) { const int mi = tid >> 6, j = tid & 63; float s = p.b_mod[l * NMOD + n0 + j];
#pragma unroll
            for (int w = 0; w < 8; ++w) s += red[(w * 3 + mi) * 64 + j];
            MOD[(size_t)(l * 3 + mi) * NMOD + n0 + j] = s; }
        __syncthreads();
    }
}

__device__ __forceinline__ void bias_rows(const bf16_t* Bt, int N, const float* sh, float* bo, int gw, int NGW, int lane) {
    float s0v[16], s1v[16];
#pragma unroll
    for (int i = 0; i < 8; ++i) { s0v[i] = sh[lane * 8 + i]; s0v[8 + i] = sh[512 + lane * 8 + i]; s1v[i] = sh[NMOD + lane * 8 + i]; s1v[8 + i] = sh[NMOD + 512 + lane * 8 + i]; }
    int n = gw;
    bf16x8 w0 = {0, 0, 0, 0, 0, 0, 0, 0}, w1 = w0;
    if (n < N) { w0 = *(const bf16x8*)(Bt + (size_t)n * D + lane * 8); w1 = *(const bf16x8*)(Bt + (size_t)n * D + 512 + lane * 8); }
    for (; n < N; n += NGW) {
        const int nn = n + NGW; bf16x8 x0 = w0, x1 = w1;
        if (nn < N) { x0 = *(const bf16x8*)(Bt + (size_t)nn * D + lane * 8); x1 = *(const bf16x8*)(Bt + (size_t)nn * D + 512 + lane * 8); }
        float s0 = 0.f, s1 = 0.f;
#pragma unroll
        for (int i = 0; i < 8; ++i) { const float a = bf2f((unsigned short)w0[i]), b = bf2f((unsigned short)w1[i]); s0 += a * s0v[i] + b * s0v[8 + i]; s1 += a * s1v[i] + b * s1v[8 + i]; }
        s0 = wave_sum(s0); s1 = wave_sum(s1);
        if (lane == 0) { bo[n] = s0; bo[N + n] = s1; }
        w0 = x0; w1 = x1;
    }
}
__device__ __forceinline__ void bias_phase(const Params& p) {
    const int tid = otid(), lane = tid & 63, wave = tid >> 6;
    const int gw = (int)blockIdx.x * 8 + wave, NGW = (int)gridDim.x * 8;
    for (int l = 0; l < DEPTH; ++l) {
        const unsigned char* wl = p.ws + WS_W + (size_t)l * WL_SIZE; const float* modl = (const float*)(p.ws + WS_MOD) + (size_t)l * 3 * NMOD; float* bl = (float*)(p.ws + WS_BIAS) + (size_t)l * BIAS_L;
        if (l > 0) bias_rows((const bf16_t*)(wl + WL_UP1), 5632, modl + 0 * D, bl + B_UP1, gw, NGW, lane);
        bias_rows((const bf16_t*)(wl + WL_WIN), 4096, modl + 3 * D, bl + B_WIN, gw, NGW, lane);
        bias_rows((const bf16_t*)(wl + WL_LRT), 32, modl + 3 * D, bl + B_LR, gw, NGW, lane);
        bias_rows((const bf16_t*)(wl + WL_UP2), 5632, modl + 6 * D, bl + B_UP2, gw, NGW, lane);
    }
}

__device__ __forceinline__ void norm_phase(const Params& p, int l, int which, int nsplit, int nrows, const float* xl_src, const float* xc_src, int ctx_only) {
    const int tid = otid(), lane = tid & 63, wave = tid >> 6;
    const int gw = (int)blockIdx.x * 8 + wave, NGW = (int)gridDim.x * 8;
    const float* nw = p.norm_w + (size_t)(l * 3 + which) * D;
    const float* MOD = (const float*)(p.ws + WS_MOD) + (size_t)l * 3 * NMOD;
    float* xc = (float*)(p.ws + WS_CX); bf16_t* H = (bf16_t*)(p.ws + WS_H);
    const int nctx = nrows - RL;
    const int nitems = ctx_only ? nctx : nrows;
    int it = gw;
    f32x4 v[4];
    if (it < nitems) { const int r = it < nctx ? RL + it : it - nctx; const f32x4* xr = (const f32x4*)(r < RL ? xl_src + (size_t)r * D : xc_src + (size_t)(r - RL) * D) + lane;
#pragma unroll
        for (int j = 0; j < 4; ++j) v[j] = xr[64 * j]; }
    for (; it < nitems; it += NGW) {
        const int r = it < nctx ? RL + it : it - nctx;
        const int itn = it + NGW; f32x4 vn[4];
#pragma unroll
        for (int j = 0; j < 4; ++j) vn[j] = v[j];
        if (itn < nitems) { const int rn = itn < nctx ? RL + itn : itn - nctx; const f32x4* xr = (const f32x4*)(rn < RL ? xl_src + (size_t)rn * D : xc_src + (size_t)(rn - RL) * D) + lane;
#pragma unroll
            for (int j = 0; j < 4; ++j) vn[j] = xr[64 * j]; }
        if (r >= RL && nsplit > 0) {
            const f32x4* sp = (const f32x4*)((const float*)(p.ws + WS_SP) + (size_t)(r - RL) * D) + lane;
            for (int kp0 = 0; kp0 < nsplit; kp0 += 4) { f32x4 t[4][4];
#pragma unroll
                for (int q = 0; q < 4; ++q) { const int kp = (kp0 + q < nsplit) ? kp0 + q : kp0;
#pragma unroll
                    for (int j = 0; j < 4; ++j) t[q][j] = sp[(size_t)kp * (RC * D / 4) + 64 * j]; }
#pragma unroll
                for (int q = 0; q < 4; ++q) { const float m = (kp0 + q < nsplit) ? 1.f : 0.f;
#pragma unroll
                    for (int j = 0; j < 4; ++j) v[j] = v[j] + t[q][j] * m; } }
            f32x4* xw = (f32x4*)(xc + (size_t)(r - RL) * D) + lane;
#pragma unroll
            for (int j = 0; j < 4; ++j) xw[64 * j] = v[j];
        }
        const float* mrow = MOD + (size_t)mod_index(r) * NMOD + (3 * which) * D;
        float s = 0.f;
#pragma unroll
        for (int j = 0; j < 4; ++j) s += (v[j][0] * v[j][0] + v[j][1] * v[j][1]) + (v[j][2] * v[j][2] + v[j][3] * v[j][3]);
        const float rstd = rsqrtf(wave_sum(s) * (1.f / D) + 1e-6f);
        u32x2* o8 = (u32x2*)(H + (size_t)r * D) + lane;
#pragma unroll
        for (int j = 0; j < 4; ++j) { const int c = 256 * j + 4 * lane;
            const f32x4 w = *(const f32x4*)(nw + c), sh = *(const f32x4*)(mrow + c), sc = *(const f32x4*)(mrow + D + c);
            const f32x4 h = (v[j] * rstd) * w * (sc + 1.f) + sh;
            u32x2 o; o.x = pk2(h[0], h[1]); o.y = pk2(h[2], h[3]); o8[64 * j] = o; }
#pragma unroll
        for (int j = 0; j < 4; ++j) v[j] = vn[j];
    }
}
__device__ __forceinline__ void final_norm(const Params& p) {
    const int tid = otid(), lane = tid & 63, wave = tid >> 6;
    const int gw = (int)blockIdx.x * 8 + wave, NGW = (int)gridDim.x * 8;
    int r = gw; f32x4 v[4];
    if (r < RL) { const f32x4* xr = (const f32x4*)(p.out + (size_t)r * D) + lane;
#pragma unroll
        for (int j = 0; j < 4; ++j) v[j] = xr[64 * j]; }
    for (; r < RL; r += NGW) {
        const int rn = r + NGW; f32x4 vn[4];
#pragma unroll
        for (int j = 0; j < 4; ++j) vn[j] = v[j];
        if (rn < RL) { const f32x4* xr = (const f32x4*)(p.out + (size_t)rn * D) + lane;
#pragma unroll
            for (int j = 0; j < 4; ++j) vn[j] = xr[64 * j]; }
        float s = 0.f;
#pragma unroll
        for (int j = 0; j < 4; ++j) s += (v[j][0] * v[j][0] + v[j][1] * v[j][1]) + (v[j][2] * v[j][2] + v[j][3] * v[j][3]);
        const float rstd = rsqrtf(wave_sum(s) * (1.f / D) + 1e-6f);
        f32x4* xo = (f32x4*)(p.out + (size_t)r * D) + lane;
#pragma unroll
        for (int j = 0; j < 4; ++j) { const f32x4 w = *(const f32x4*)(p.final_norm_w + 256 * j + 4 * lane); xo[64 * j] = (v[j] * rstd) * w; }
#pragma unroll
        for (int j = 0; j < 4; ++j) v[j] = vn[j];
    }
}

__device__ __forceinline__ void lowrank_phase(const Params& p, int l, int vblk, const float* sq, const float* bias) {
    const int tid = otid(), lane = tid & 63, wave = tid >> 6, fr = lane & 15, fq = lane >> 4;
    const int skip = (int)gridDim.x > 64 ? 32 : 0;
    if (vblk < skip) return;
    const int gw = (vblk - skip) * 8 + wave, NGW = ((int)gridDim.x - skip) * 8;
    const bf16_t* H = (const bf16_t*)(p.ws + WS_H); const bf16_t* lrt = (const bf16_t*)(p.ws + WS_W + (size_t)l * WL_SIZE + WL_LRT);
    float* LR = (float*)(p.ws + WS_LR);
    for (int it = gw; it < R / 16; it += NGW) {
        const int r0 = it * 16;
        const bf16_t* ap = H + (size_t)(r0 + fr) * D + fq * 8; const bf16_t* bp = lrt + (size_t)fr * D + fq * 8;
        f32x4 acc0 = {0.f, 0.f, 0.f, 0.f}, acc1 = {0.f, 0.f, 0.f, 0.f};
#pragma unroll 4
        for (int ks = 0; ks < 32; ++ks) { const bf16x8 a = *(const bf16x8*)(ap + ks * 32), b0 = *(const bf16x8*)(bp + ks * 32), b1 = *(const bf16x8*)(bp + 16 * D + ks * 32);
            acc0 = __builtin_amdgcn_mfma_f32_16x16x32_bf16(a, b0, acc0, 0, 0, 0); acc1 = __builtin_amdgcn_mfma_f32_16x16x32_bf16(a, b1, acc1, 0, 0, 0); }
        const bool fz = (sq != nullptr) && (r0 < RL);
        const float bl = fz ? bias[(r0 < SEQ ? 0 : 32) + fr] : 0.f, bh = fz ? bias[(r0 < SEQ ? 0 : 32) + 16 + fr] : 0.f;
#pragma unroll
        for (int j = 0; j < 4; ++j) { const int r = r0 + fq * 4 + j; const float rstd = fz ? rsqrtf(sq[r] * (1.f / D) + 1e-6f) : 1.f;
            float* o = LR + (size_t)r * 32 + fr; o[0] = acc0[j] * rstd + bl; o[16] = acc1[j] * rstd + bh; }
    }
}

__device__ __forceinline__ void ctx_branch_direct(const Params& p, int l) {
    const int tid = otid(), lane = tid & 63, wave = tid >> 6, fr = lane & 15, fq = lane >> 4;
    const int gw = (int)blockIdx.x * 8 + wave, NGW = (int)gridDim.x * 8;
    const bf16_t* Pm = (const bf16_t*)(p.ws + WS_P); const bf16_t* GOm = (const bf16_t*)(p.ws + WS_H); const bf16_t* PGm = (const bf16_t*)(p.ws + WS_PG); bf16_t* MGm = (bf16_t*)(p.ws + WS_PA);
    const bf16_t* wpt = (const bf16_t*)(p.ws + WS_W + (size_t)l * WL_SIZE + WL_WPT); const bf16_t* wgt = (const bf16_t*)(p.ws + WS_W + (size_t)l * WL_SIZE + WL_WGT);
    for (int it = gw; it < (RC / 16) * 16 * 4; it += NGW) {
        if ((it & 3) != 0) continue;
        const int item = it >> 2, r0 = RL + (item >> 4) * 16, n0 = (item & 15) * 64;
        const bf16_t* ap = Pm + (size_t)(r0 + fr) * 512 + fq * 8; const bf16_t* ag = GOm + (size_t)(r0 + fr) * 512 + fq * 8;
        const bf16_t* bp = wpt + (size_t)(n0 + fr) * 512 + fq * 8; const bf16_t* bg = wgt + (size_t)(n0 + fr) * 512 + fq * 8;
        f32x4 accp[4], accg[4];
#pragma unroll
        for (int jt = 0; jt < 4; ++jt) { accp[jt] = (f32x4){0.f, 0.f, 0.f, 0.f}; accg[jt] = accp[jt]; }
#pragma unroll 2
        for (int ks = 0; ks < 16; ++ks) { const bf16x8 a0 = *(const bf16x8*)(ap + ks * 32), a1 = *(const bf16x8*)(ag + ks * 32);
#pragma unroll
            for (int jt = 0; jt < 4; ++jt) { const bf16x8 b0 = *(const bf16x8*)(bp + (size_t)jt * 16 * 512 + ks * 32), b1 = *(const bf16x8*)(bg + (size_t)jt * 16 * 512 + ks * 32);
                accp[jt] = __builtin_amdgcn_mfma_f32_16x16x32_bf16(a0, b0, accp[jt], 0, 0, 0); accg[jt] = __builtin_amdgcn_mfma_f32_16x16x32_bf16(a1, b1, accg[jt], 0, 0, 0); } }
        unsigned short gpv[4][4], ggv[4][4];
#pragma unroll
        for (int jt = 0; jt < 4; ++jt)
#pragma unroll
            for (int j = 0; j < 4; ++j) { const bf16_t* gr = PGm + (size_t)(r0 + fq * 4 + j) * PAW + n0 + jt * 16 + fr; gpv[jt][j] = gr[0]; ggv[jt][j] = gr[1024]; }
#pragma unroll
        for (int jt = 0; jt < 4; ++jt)
#pragma unroll
            for (int j = 0; j < 4; ++j) MGm[(size_t)(r0 + fq * 4 + j) * 1024 + n0 + jt * 16 + fr] = (bf16_t)f2bf(sigmoidf_(bf2f(gpv[jt][j])) * accp[jt][j] + sigmoidf_(bf2f(ggv[jt][j])) * accg[jt][j]);
    }
}

#define LBAR() do { asm volatile("s_waitcnt lgkmcnt(0)" ::: "memory"); __builtin_amdgcn_s_barrier(); asm volatile("" ::: "memory"); } while (0)
#define LWAIT() asm volatile("s_waitcnt lgkmcnt(0)" ::: "memory")
constexpr int BP = 68;
constexpr int LP = 72;
constexpr int NGI = NCHUNK * 4;

struct GateIn { float a[4][4]; float bw[4]; float bias; };
__device__ __forceinline__ void gates_load(const Params& p, int l, int it, int lane, int wave, GateIn& g) {
    const int r0 = (it >> 2) * 64, h = it & 3, col = lane & 15, quad = lane >> 4, dir = wave >> 2, dkt = wave & 3;
    const float* LR = (const float*)(p.ws + WS_LR) + (size_t)r0 * 32 + dir * 16 + quad;
    const float* wup = (dir == 0 ? p.w_af_up : p.w_ab_up) + (size_t)l * 16 * 256 + h * 64 + dkt * 16 + col;
    g.bias = (dir == 0 ? p.b_af : p.b_ab)[l * 256 + h * 64 + dkt * 16 + col];
#pragma unroll
    for (int kq = 0; kq < 4; ++kq) g.bw[kq] = wup[(kq * 4 + quad) * 256];
#pragma unroll
    for (int ct = 0; ct < 4; ++ct)
#pragma unroll
        for (int kq = 0; kq < 4; ++kq) g.a[ct][kq] = LR[(size_t)(ct * 16 + col) * 32 + kq * 4];
}
__device__ __forceinline__ void gates_compute(const GateIn& gi, int lane, int wave, LAS float* Bf, LAS float* Bb) {
    const int col = lane & 15, quad = lane >> 4, dir = wave >> 2, dkt = wave & 3;
    float run = 0.f; float pex[4][4];
#pragma unroll
    for (int ct = 0; ct < 4; ++ct) {
        f32x4 acc = {gi.bias, gi.bias, gi.bias, gi.bias};
#pragma unroll
        for (int kq = 0; kq < 4; ++kq) acc = __builtin_amdgcn_mfma_f32_16x16x4f32(gi.a[ct][kq], gi.bw[kq], acc, 0, 0, 0);
        float g[4], pi[4];
#pragma unroll
        for (int j = 0; j < 4; ++j) { const float x = acc[j]; g[j] = (fminf(x, 0.f) - __logf(1.f + __expf(-fabsf(x)))) * (1.f / 16.f); }
        pi[0] = g[0]; pi[1] = pi[0] + g[1]; pi[2] = pi[1] + g[2]; pi[3] = pi[2] + g[3];
        const float t = pi[3];
        const float t0 = __shfl(t, col), t1 = __shfl(t, col + 16), t2 = __shfl(t, col + 32), t3 = __shfl(t, col + 48);
        const float offs = run + (quad > 0 ? t0 : 0.f) + (quad > 1 ? t1 : 0.f) + (quad > 2 ? t2 : 0.f);
        run += (t0 + t1) + (t2 + t3);
        if (dir == 0) {
#pragma unroll
            for (int j = 0; j < 4; ++j) Bf[(ct * 16 + quad * 4 + j) * BP + dkt * 16 + col] = offs + pi[j]; }
#pragma unroll
        for (int j = 0; j < 4; ++j) pex[ct][j] = offs + pi[j] - g[j];
    }
    if (dir == 1) {
#pragma unroll
        for (int ct = 0; ct < 4; ++ct)
#pragma unroll
            for (int j = 0; j < 4; ++j) Bb[(ct * 16 + quad * 4 + j) * BP + dkt * 16 + col] = run - pex[ct][j]; }
}

template <int HALF>
__device__ __forceinline__ void pool_vertical(const bf16_t* basep, int Rr, int col, float (&acc)[16], float (&uc)[16]) {
#pragma unroll
    for (int i = 0; i < 16; ++i) { acc[i] = 0.f; uc[i] = 0.f; }
#pragma unroll
    for (int o = -HALF; o < HALF; ++o) { const int rr = Rr + o; const bool ok = (rr >= 0) && (rr < 128); const int rc = ok ? rr : Rr;
        const bf16_t* pp = basep + (size_t)(rc * 64 + col) * PAW; const bf16x8 a0 = *(const bf16x8*)pp, a1 = *(const bf16x8*)(pp + 8);
        const float m = ok ? 1.f : 0.f;
#pragma unroll
        for (int i = 0; i < 8; ++i) { const float f0 = bf2f((unsigned short)a0[i]), f1 = bf2f((unsigned short)a1[i]); acc[i] += m * f0; acc[8 + i] += m * f1; if (o == 0) { uc[i] = f0; uc[8 + i] = f1; } } }
}

__device__ __forceinline__ void gla_kv_phase(const Params& p, int l, LAS unsigned char* lds) {
    const int tid = otid(), lane = tid & 63, wave = tid >> 6, fr = lane & 15, fq = lane >> 4, G = gridDim.x;
    LAS float* Bf = (LAS float*)lds; LAS float* Bb = (LAS float*)(lds + 17408);
    LAS bf16_t* keT0 = (LAS bf16_t*)(lds + 34816); LAS bf16_t* keT1 = (LAS bf16_t*)(lds + 34816 + 9216); LAS bf16_t* vT = (LAS bf16_t*)(lds + 34816 + 18432);
    const bf16_t* PA = (const bf16_t*)(p.ws + WS_PA); bf16_t* KV = (bf16_t*)(p.ws + WS_KV); float* DEC = (float*)(p.ws + WS_DEC);
    const int c = tid & 63, sub = tid >> 6;
    GateIn gc; bf16x8 kk = {0, 0, 0, 0, 0, 0, 0, 0}, v0 = kk, v1 = kk;
    int it = blockIdx.x;
    if (it < NGI) { gates_load(p, l, it, lane, wave, gc); const bf16_t* rowp = PA + (size_t)((it >> 2) * 64 + c) * PAW; const int h = it & 3;
        kk = *(const bf16x8*)(rowp + PA_K + h * 64 + sub * 8); v0 = *(const bf16x8*)(rowp + PA_V + h * 128 + sub * 16); v1 = *(const bf16x8*)(rowp + PA_V + h * 128 + sub * 16 + 8); }
    for (; it < NGI; it += G) {
        const int nit = it + G; GateIn gn = gc; bf16x8 nkk = kk, nv0 = v0, nv1 = v1;
        if (nit < NGI) { gates_load(p, l, nit, lane, wave, gn); const bf16_t* rowp = PA + (size_t)((nit >> 2) * 64 + c) * PAW; const int h = nit & 3;
            nkk = *(const bf16x8*)(rowp + PA_K + h * 64 + sub * 8); nv0 = *(const bf16x8*)(rowp + PA_V + h * 128 + sub * 16); nv1 = *(const bf16x8*)(rowp + PA_V + h * 128 + sub * 16 + 8); }
        gates_compute(gc, lane, wave, Bf, Bb);
        LBAR();
        { const f32x4 bf0 = *(const LAS f32x4*)(Bf + c * BP + sub * 8), bf1 = *(const LAS f32x4*)(Bf + c * BP + sub * 8 + 4);
          const f32x4 bb0 = *(const LAS f32x4*)(Bb + c * BP + sub * 8), bb1 = *(const LAS f32x4*)(Bb + c * BP + sub * 8 + 4);
          const f32x4 tf0 = *(const LAS f32x4*)(Bf + 63 * BP + sub * 8), tf1 = *(const LAS f32x4*)(Bf + 63 * BP + sub * 8 + 4);
          const f32x4 tb0 = *(const LAS f32x4*)(Bb + sub * 8), tb1 = *(const LAS f32x4*)(Bb + sub * 8 + 4);
#pragma unroll
          for (int i = 0; i < 8; ++i) { const int dk = sub * 8 + i; const float kf = bf2f((unsigned short)kk[i]);
              const float bfv = i < 4 ? bf0[i & 3] : bf1[i & 3], bbv = i < 4 ? bb0[i & 3] : bb1[i & 3], tfv = i < 4 ? tf0[i & 3] : tf1[i & 3], tbv = i < 4 ? tb0[i & 3] : tb1[i & 3];
              keT0[dk * LP + c] = (bf16_t)f2bf(kf * __expf(tfv - bfv));
              keT1[dk * LP + c] = (bf16_t)f2bf(kf * __expf(tbv - bbv)); }
#pragma unroll
          for (int i = 0; i < 8; ++i) { vT[(sub * 16 + i) * LP + c] = (bf16_t)v0[i]; vT[(sub * 16 + 8 + i) * LP + c] = (bf16_t)v1[i]; } }
        if (tid < 128) { const int d = tid >> 6, dk = tid & 63; DEC[(size_t)(it * 2 + d) * 64 + dk] = __expf(d == 0 ? Bf[63 * BP + dk] : Bb[dk]); }
        LBAR();
        { const int e0 = wave * 16;
          bf16x8 bv[2];
#pragma unroll
          for (int ks = 0; ks < 2; ++ks) bv[ks] = *(const LAS bf16x8*)(vT + (e0 + fr) * LP + ks * 32 + fq * 8);
#pragma unroll
          for (int d = 0; d < 2; ++d) { const LAS bf16_t* ke = d == 0 ? keT0 : keT1; bf16_t* dst = KV + (size_t)(it * 2 + d) * 8192 + (size_t)(e0 + fr) * 64;
#pragma unroll
              for (int dt = 0; dt < 4; ++dt) { f32x4 acc = {0.f, 0.f, 0.f, 0.f};
#pragma unroll
                  for (int ks = 0; ks < 2; ++ks) { const bf16x8 a = *(const LAS bf16x8*)(ke + (dt * 16 + fr) * LP + ks * 32 + fq * 8); acc = __builtin_amdgcn_mfma_f32_16x16x32_bf16(a, bv[ks], acc, 0, 0, 0); }
                  u32x2 w; w.x = pk2(acc[0], acc[1]); w.y = pk2(acc[2], acc[3]); *(u32x2*)(dst + dt * 16 + fq * 4) = w; } } }
        LBAR();
        gc = gn; kk = nkk; v0 = nv0; v1 = nv1;
    }
    bf16_t* P = (bf16_t*)(p.ws + WS_P);
    LAS float* cs = (LAS float*)lds; constexpr int CSP = 132;
    for (int pit = blockIdx.x; pit < NB * 128 * 4; pit += G) {
        const int pq = pit >> 8, pc = pit & 255, gi = (pc + pq) & 3, pidx = pq * 64 + (pc >> 2), Rr = pidx & 127, b = pidx >> 7, half = 1 << gi;
        const int rlo = max(Rr - half, 0), rhi = min(Rr + half, 128);
        const int col = tid >> 3, ch0 = (tid & 7) * 16;
        const bf16_t* basep = PA + (size_t)(b * SEQ) * PAW + PA_P + gi * 128 + ch0;
        float acc[16], uc[16];
        if (gi == 0) pool_vertical<1>(basep, Rr, col, acc, uc); else if (gi == 1) pool_vertical<2>(basep, Rr, col, acc, uc);
        else if (gi == 2) pool_vertical<4>(basep, Rr, col, acc, uc); else pool_vertical<8>(basep, Rr, col, acc, uc);
#pragma unroll
        for (int i = 0; i < 4; ++i) *(LAS f32x4*)(cs + col * CSP + ch0 + 4 * i) = (f32x4){acc[4 * i], acc[4 * i + 1], acc[4 * i + 2], acc[4 * i + 3]};
        LBAR();
        const int clo = max(col - half, 0), chi = min(col + half, 64);
        f32x4 sum[4];
#pragma unroll
        for (int i = 0; i < 4; ++i) sum[i] = (f32x4){0.f, 0.f, 0.f, 0.f};
        for (int cc = clo; cc < chi; ++cc) {
#pragma unroll
            for (int i = 0; i < 4; ++i) sum[i] = sum[i] + *(const LAS f32x4*)(cs + cc * CSP + ch0 + 4 * i); }
        const float inv = 1.f / (float)((rhi - rlo) * (chi - clo));
        bf16_t* op = P + (size_t)(b * SEQ + Rr * 64 + col) * 512 + gi * 128 + ch0;
        u32x4 w0, w1;
        w0.x = pk2(sum[0][0] * inv - uc[0], sum[0][1] * inv - uc[1]); w0.y = pk2(sum[0][2] * inv - uc[2], sum[0][3] * inv - uc[3]);
        w0.z = pk2(sum[1][0] * inv - uc[4], sum[1][1] * inv - uc[5]); w0.w = pk2(sum[1][2] * inv - uc[6], sum[1][3] * inv - uc[7]);
        w1.x = pk2(sum[2][0] * inv - uc[8], sum[2][1] * inv - uc[9]); w1.y = pk2(sum[2][2] * inv - uc[10], sum[2][3] * inv - uc[11]);
        w1.z = pk2(sum[3][0] * inv - uc[12], sum[3][1] * inv - uc[13]); w1.w = pk2(sum[3][2] * inv - uc[14], sum[3][3] * inv - uc[15]);
        *(u32x4*)op = w0; *(u32x4*)(op + 8) = w1;
        LBAR();
    }
    for (int idx = (int)blockIdx.x * 512 + tid; idx < RC * 32; idx += G * 512) {
        const int tok = idx >> 5, ch0 = (idx & 31) * 16, gi = ch0 >> 7, half = 1 << gi, b = tok >> 8, t = tok & 255;
        const int lo = max(t - half, 0), hi = min(t + half, CTXL);
        const bf16_t* basep = PA + (size_t)(RL + b * CTXL) * PAW + PA_P + ch0;
        float acc[16], uc[16];
#pragma unroll
        for (int i = 0; i < 16; ++i) { acc[i] = 0.f; uc[i] = 0.f; }
        for (int tt = lo; tt < hi; ++tt) { const bf16_t* pp = basep + (size_t)tt * PAW; const bf16x8 a0 = *(const bf16x8*)pp, a1 = *(const bf16x8*)(pp + 8);
            const bool ctr = (tt == t);
#pragma unroll
            for (int i = 0; i < 8; ++i) { const float f0 = bf2f((unsigned short)a0[i]), f1 = bf2f((unsigned short)a1[i]); acc[i] += f0; acc[8 + i] += f1; if (ctr) { uc[i] = f0; uc[8 + i] = f1; } } }
        const float inv = 1.f / (float)(hi - lo);
        bf16_t* op = P + (size_t)(RL + tok) * 512 + ch0;
        u32x4 w0, w1;
        w0.x = pk2(acc[0] * inv - uc[0], acc[1] * inv - uc[1]); w0.y = pk2(acc[2] * inv - uc[2], acc[3] * inv - uc[3]);
        w0.z = pk2(acc[4] * inv - uc[4], acc[5] * inv - uc[5]); w0.w = pk2(acc[6] * inv - uc[6], acc[7] * inv - uc[7]);
        w1.x = pk2(acc[8] * inv - uc[8], acc[9] * inv - uc[9]); w1.y = pk2(acc[10] * inv - uc[10], acc[11] * inv - uc[11]);
        w1.z = pk2(acc[12] * inv - uc[12], acc[13] * inv - uc[13]); w1.w = pk2(acc[14] * inv - uc[14], acc[15] * inv - uc[15]);
        *(u32x4*)op = w0; *(u32x4*)(op + 8) = w1;
    }
}

__device__ __forceinline__ int scan_item(int step, int b, int h, int d) {
    int cgi;
    if (step < 4) cgi = 256 + b * 4 + (d == 0 ? step : 3 - step);
    else cgi = b * 128 + (d == 0 ? step - 4 : 127 - (step - 4));
    return (cgi * 4 + h) * 2 + d;
}
__device__ __forceinline__ void gla_scan_phase(const Params& p) {
    bf16_t* KV = (bf16_t*)(p.ws + WS_KV); const float* DEC = (const float*)(p.ws + WS_DEC);
    for (int idx = (int)blockIdx.x * 512 + otid(); idx < 16 * 8192; idx += (int)gridDim.x * 512) {
        const int sid = idx >> 13, el = idx & 8191, dk = el & 63, d = sid & 1, h = (sid >> 1) & 3, b = sid >> 3;
        float s = 0.f;
        { float kv[4], dc[4]; int item[4];
#pragma unroll
          for (int i = 0; i < 4; ++i) { item[i] = scan_item(i, b, h, d); kv[i] = bf2f(KV[(size_t)item[i] * 8192 + el]); dc[i] = DEC[(size_t)item[i] * 64 + dk]; }
#pragma unroll
          for (int i = 0; i < 4; ++i) { KV[(size_t)item[i] * 8192 + el] = (bf16_t)f2bf(s); s = s * dc[i] + kv[i]; } }
        for (int s0 = 4; s0 < 132; s0 += 32) { float kv[32], dc[32]; int item[32];
#pragma unroll
          for (int i = 0; i < 32; ++i) { item[i] = scan_item(s0 + i, b, h, d); kv[i] = bf2f(KV[(size_t)item[i] * 8192 + el]); dc[i] = DEC[(size_t)item[i] * 64 + dk]; }
#pragma unroll
          for (int i = 0; i < 32; ++i) { KV[(size_t)item[i] * 8192 + el] = (bf16_t)f2bf(s); s = s * dc[i] + kv[i]; } }
    }
}

__device__ __forceinline__ void gla_out_phase(const Params& p, int l, LAS unsigned char* lds, int nitems) {
    const int tid = otid(), lane = tid & 63, wave = tid >> 6, fr = lane & 15, fq = lane >> 4, G = gridDim.x;
    LAS float* Bf = (LAS float*)lds; LAS float* Bb = (LAS float*)(lds + 17408);
    LAS bf16_t* qt0 = (LAS bf16_t*)(lds + 34816); LAS bf16_t* qt1 = (LAS bf16_t*)(lds + 34816 + 9216);
    LAS bf16_t* kt0 = (LAS bf16_t*)(lds + 34816 + 2 * 9216); LAS bf16_t* kt1 = (LAS bf16_t*)(lds + 34816 + 3 * 9216);
    LAS bf16_t* vT = (LAS bf16_t*)(lds + 34816 + 4 * 9216);
    LAS bf16_t* attw = (LAS bf16_t*)(lds + 34816 + 4 * 9216 + 18432) + wave * (16 * LP);
    LAS float* red = (LAS float*)(lds + 34816 + 4 * 9216 + 18432 + 8 * 16 * LP * 2);
    const bf16_t* PA = (const bf16_t*)(p.ws + WS_PA); const bf16_t* KV = (const bf16_t*)(p.ws + WS_KV); bf16_t* GO = (bf16_t*)(p.ws + WS_H);
    const float* gnw = p.gla_norm_w + l * 128;
    const int ct = wave & 3, eh = wave >> 2, c = tid & 63, sub = tid >> 6;
    GateIn gc; bf16x8 qq = {0, 0, 0, 0, 0, 0, 0, 0}, kk = qq, v0 = qq, v1 = qq;
    int it = blockIdx.x;
    if (it < nitems) { gates_load(p, l, it, lane, wave, gc); const bf16_t* rowp = PA + (size_t)((it >> 2) * 64 + c) * PAW; const int h = it & 3;
        qq = *(const bf16x8*)(rowp + PA_Q + h * 64 + sub * 8); kk = *(const bf16x8*)(rowp + PA_K + h * 64 + sub * 8);
        v0 = *(const bf16x8*)(rowp + PA_V + h * 128 + sub * 16); v1 = *(const bf16x8*)(rowp + PA_V + h * 128 + sub * 16 + 8); }
    for (; it < nitems; it += G) {
        const int h = it & 3, r0 = (it >> 2) * 64;
        bf16x8 bs[2][4][2];
#pragma unroll
        for (int d = 0; d < 2; ++d)
#pragma unroll
            for (int et = 0; et < 4; ++et)
#pragma unroll
                for (int ks = 0; ks < 2; ++ks) bs[d][et][ks] = *(const bf16x8*)(KV + (size_t)(it * 2 + d) * 8192 + (size_t)(eh * 64 + et * 16 + fr) * 64 + ks * 32 + fq * 8);
        const int nit = it + G; GateIn gn = gc; bf16x8 nqq = qq, nkk = kk, nv0 = v0, nv1 = v1;
        if (nit < nitems) { gates_load(p, l, nit, lane, wave, gn); const bf16_t* rowp = PA + (size_t)((nit >> 2) * 64 + c) * PAW; const int nh = nit & 3;
            nqq = *(const bf16x8*)(rowp + PA_Q + nh * 64 + sub * 8); nkk = *(const bf16x8*)(rowp + PA_K + nh * 64 + sub * 8);
            nv0 = *(const bf16x8*)(rowp + PA_V + nh * 128 + sub * 16); nv1 = *(const bf16x8*)(rowp + PA_V + nh * 128 + sub * 16 + 8); }
        gates_compute(gc, lane, wave, Bf, Bb);
        LBAR();
        { const f32x4 bf0 = *(const LAS f32x4*)(Bf + c * BP + sub * 8), bf1 = *(const LAS f32x4*)(Bf + c * BP + sub * 8 + 4);
          const f32x4 bb0 = *(const LAS f32x4*)(Bb + c * BP + sub * 8), bb1 = *(const LAS f32x4*)(Bb + c * BP + sub * 8 + 4);
          u32x4 w;
          { float qf[8], qb[8];
#pragma unroll
            for (int i = 0; i < 8; ++i) { const float q = bf2f((unsigned short)qq[i]); const float bf = i < 4 ? bf0[i & 3] : bf1[i & 3], bb = i < 4 ? bb0[i & 3] : bb1[i & 3]; qf[i] = q * __expf(bf); qb[i] = q * __expf(bb); }
            w.x = pk2(qf[0], qf[1]); w.y = pk2(qf[2], qf[3]); w.z = pk2(qf[4], qf[5]); w.w = pk2(qf[6], qf[7]); *(LAS u32x4*)(qt0 + c * LP + sub * 8) = w;
            w.x = pk2(qb[0], qb[1]); w.y = pk2(qb[2], qb[3]); w.z = pk2(qb[4], qb[5]); w.w = pk2(qb[6], qb[7]); *(LAS u32x4*)(qt1 + c * LP + sub * 8) = w; }
          { float kf[8], kb[8];
#pragma unroll
            for (int i = 0; i < 8; ++i) { const float k = bf2f((unsigned short)kk[i]); const float bf = i < 4 ? bf0[i & 3] : bf1[i & 3], bb = i < 4 ? bb0[i & 3] : bb1[i & 3]; kf[i] = k * __expf(-bf); kb[i] = k * __expf(-bb); }
            w.x = pk2(kf[0], kf[1]); w.y = pk2(kf[2], kf[3]); w.z = pk2(kf[4], kf[5]); w.w = pk2(kf[6], kf[7]); *(LAS u32x4*)(kt0 + c * LP + sub * 8) = w;
            w.x = pk2(kb[0], kb[1]); w.y = pk2(kb[2], kb[3]); w.z = pk2(kb[4], kb[5]); w.w = pk2(kb[6], kb[7]); *(LAS u32x4*)(kt1 + c * LP + sub * 8) = w; }
#pragma unroll
          for (int i = 0; i < 8; ++i) { vT[(sub * 16 + i) * LP + c] = (bf16_t)v0[i]; vT[(sub * 16 + 8 + i) * LP + c] = (bf16_t)v1[i]; } }
        LBAR();
        unsigned short rg[4][4];
#pragma unroll
        for (int j = 0; j < 4; ++j)
#pragma unroll
            for (int et = 0; et < 4; ++et) rg[j][et] = PA[(size_t)(r0 + ct * 16 + fq * 4 + j) * PAW + PA_R + h * 128 + eh * 64 + et * 16 + fr];
        f32x4 acco[4];
#pragma unroll
        for (int et = 0; et < 4; ++et) acco[et] = (f32x4){0.f, 0.f, 0.f, 0.f};
#pragma unroll
        for (int d = 0; d < 2; ++d) {
            const LAS bf16_t* qt = d == 0 ? qt0 : qt1; const LAS bf16_t* kt = d == 0 ? kt0 : kt1;
            bf16x8 aq[2];
#pragma unroll
            for (int ks = 0; ks < 2; ++ks) aq[ks] = *(const LAS bf16x8*)(qt + (ct * 16 + fr) * LP + ks * 32 + fq * 8);
#pragma unroll
            for (int mt = 0; mt < 4; ++mt) { f32x4 sacc = {0.f, 0.f, 0.f, 0.f};
#pragma unroll
                for (int ks = 0; ks < 2; ++ks) { const bf16x8 bk = *(const LAS bf16x8*)(kt + (mt * 16 + fr) * LP + ks * 32 + fq * 8); sacc = __builtin_amdgcn_mfma_f32_16x16x32_bf16(aq[ks], bk, sacc, 0, 0, 0); }
                const int mm = mt * 16 + fr;
#pragma unroll
                for (int j = 0; j < 4; ++j) { const int cc = ct * 16 + fq * 4 + j; const bool keep = d == 0 ? (mm <= cc) : (mm > cc);
                    attw[(fq * 4 + j) * LP + mm] = (bf16_t)f2bf(keep ? sacc[j] : 0.f); } }
            LWAIT();
            bf16x8 aa[2];
#pragma unroll
            for (int ks = 0; ks < 2; ++ks) aa[ks] = *(const LAS bf16x8*)(attw + fr * LP + ks * 32 + fq * 8);
#pragma unroll
            for (int et = 0; et < 4; ++et) { const int e = eh * 64 + et * 16 + fr;
#pragma unroll
                for (int ks = 0; ks < 2; ++ks) { const bf16x8 bv = *(const LAS bf16x8*)(vT + e * LP + ks * 32 + fq * 8); acco[et] = __builtin_amdgcn_mfma_f32_16x16x32_bf16(aa[ks], bv, acco[et], 0, 0, 0); }
#pragma unroll
                for (int ks = 0; ks < 2; ++ks) acco[et] = __builtin_amdgcn_mfma_f32_16x16x32_bf16(aq[ks], bs[d][et][ks], acco[et], 0, 0, 0); }
            LWAIT();
        }
        float ss[4];
#pragma unroll
        for (int j = 0; j < 4; ++j) { float t = 0.f;
#pragma unroll
            for (int et = 0; et < 4; ++et) t += acco[et][j] * acco[et][j];
            t += __shfl_xor(t, 1); t += __shfl_xor(t, 2); t += __shfl_xor(t, 4); t += __shfl_xor(t, 8); ss[j] = t; }
        if (fr == 0) {
#pragma unroll
            for (int j = 0; j < 4; ++j) red[eh * 64 + ct * 16 + fq * 4 + j] = ss[j]; }
        LBAR();
#pragma unroll
        for (int j = 0; j < 4; ++j) { const int cc = ct * 16 + fq * 4 + j; const float rstd = rsqrtf((red[cc] + red[64 + cc]) * (1.f / 128.f) + 1e-6f);
            bf16_t* orow = GO + (size_t)(r0 + cc) * 512 + h * 128;
#pragma unroll
            for (int et = 0; et < 4; ++et) { const int e = eh * 64 + et * 16 + fr;
                orow[e] = (bf16_t)f2bf(acco[et][j] * rstd * gnw[e] * siluf_(bf2f(rg[j][et]))); } }
        LBAR();
        gc = gn; qq = nqq; kk = nkk; v0 = nv0; v1 = nv1;
    }
}

#define XB_TMO      128
#define XB_XCNT(j)  (256  + 64 * (j))
#define XB_XSUB(j)  (1280 + 64 * (j))
#define XB_XGEN(j)  (2304 + 64 * (j))
#define XB_TOP      3328
#define XB_TOPGEN   3392
#define XCD_BAR_WORDS 3456
#define XB_SPIN_CAP (1u << 18)

__device__ __forceinline__ unsigned xb_ld(unsigned* p)              { return __hip_atomic_load(p, __ATOMIC_RELAXED, __HIP_MEMORY_SCOPE_AGENT); }
__device__ __forceinline__ unsigned xb_add(unsigned* p, unsigned v) { return __hip_atomic_fetch_add(p, v, __ATOMIC_RELAXED, __HIP_MEMORY_SCOPE_AGENT); }
__device__ __forceinline__ unsigned xb_xcc_id() { return (unsigned)__builtin_amdgcn_s_getreg((3 << 11) | 20) & 0xFu; }
#define XB_SPIN(cond, bar) do { unsigned _sp = 0; while (cond) { __builtin_amdgcn_s_sleep(1); \
    if ((++_sp & 255u) == 0u) { if (xb_ld(&(bar)[XB_TMO])) break; if (_sp > XB_SPIN_CAP) { atomicAdd(&(bar)[XB_TMO], 1u); break; } } } } while (0)

#define RLX_AGENT __ATOMIC_RELAXED, __HIP_MEMORY_SCOPE_AGENT
struct XcdBarrier {
    unsigned* bar; unsigned x;
    volatile LAS unsigned* st;
};

__device__ __forceinline__ XcdBarrier xcd_barrier_post(unsigned* bar, volatile LAS unsigned* st) {
    XcdBarrier b; b.bar = bar; b.x = xb_xcc_id(); b.st = st;
    if (threadIdx.x == 0) (void)xb_add(&bar[XB_XCNT(b.x)], 1u);
    return b;
}
__device__ __forceinline__ void xcd_barrier_complete(unsigned* bar, unsigned x, unsigned& nloc, unsigned& nx) {
    const unsigned G = gridDim.x * gridDim.y * gridDim.z;
    unsigned sum, cnt, mine, sp = 0u;
    for (;;) {
        sum = 0u; cnt = 0u; mine = 0u;
#pragma unroll
        for (unsigned j = 0; j < 16; ++j) { const unsigned c = xb_ld(&bar[XB_XCNT(j)]); sum += c; cnt += (c > 0u) ? 1u : 0u; mine = (j == x) ? c : mine; }
        if (sum == G) break;
        __builtin_amdgcn_s_sleep(1);
        if ((++sp & 255u) == 0u) { if (xb_ld(&bar[XB_TMO])) break; if (sp > XB_SPIN_CAP) { atomicAdd(&bar[XB_TMO], 1u); break; } }
    }
    nloc = mine > 0u ? mine : 1u; nx = cnt > 0u ? cnt : 1u;
}

__device__ __forceinline__ void xcd_barrier(const XcdBarrier& b) {
    asm volatile("s_waitcnt vmcnt(0)" ::: "memory");
    __syncthreads();
    if (threadIdx.x == 0) {
        unsigned* bar = b.bar;
        __builtin_amdgcn_s_waitcnt(0);
        unsigned nloc = b.st[0], nx = b.st[1];
        if (nloc == 0u) { xcd_barrier_complete(bar, b.x, nloc, nx); b.st[0] = nloc; b.st[1] = nx; }
        const unsigned old = xb_add(&bar[XB_XSUB(b.x)], 1u);
        const unsigned gen = old / nloc;
        if (old + 1u == (gen + 1u) * nloc) {
            __builtin_amdgcn_fence(__ATOMIC_RELEASE, "agent");
            asm volatile("s_waitcnt vmcnt(0)" ::: "memory");
            const unsigned og = xb_add(&bar[XB_TOP], 1u);
            const unsigned tg = og / nx;
            if (og + 1u == (tg + 1u) * nx) xb_add(&bar[XB_TOPGEN], 1u);
            else XB_SPIN(xb_ld(&bar[XB_TOPGEN]) == tg, bar);
            __builtin_amdgcn_fence(__ATOMIC_ACQUIRE, "agent");
            xb_add(&bar[XB_XGEN(b.x)], 1u);
            asm volatile("s_waitcnt vmcnt(0)" ::: "memory");
        } else {
            XB_SPIN(xb_ld(&bar[XB_XGEN(b.x)]) == gen, bar);
            __builtin_amdgcn_fence(__ATOMIC_ACQUIRE, "agent");
            asm volatile("s_waitcnt vmcnt(0)" ::: "memory");
        }
    }
    __syncthreads();
}
constexpr int NPHASE = 2 + DEPTH * 14;
constexpr size_t WS_BAR = (WS_END + 255) & ~(size_t)255;
constexpr size_t WS_FCNT = WS_BAR + XCD_BAR_WORDS * 4;
constexpr size_t WS_TOTAL = WS_FCNT + 64 * 256;
constexpr int LDS_BARST = 131072;
#ifndef FUSE_A
#define FUSE_A 1
#endif
#ifndef FUSE_B
#define FUSE_B 1
#endif
#ifndef PROBE_MASK
#define PROBE_MASK 0
#endif
__global__ void __launch_bounds__(512, 2) fwd_megakernel(Params p_karg) {
    extern __shared__ __attribute__((aligned(16))) unsigned char lds_raw[];
    LAS unsigned char* lds = (LAS unsigned char*)lds_raw;
    cg::grid_group grid = cg::this_grid();
    if (threadIdx.x < 4) ((volatile LAS unsigned*)(lds + LDS_BARST))[threadIdx.x] = 0u;
    __syncthreads();
    if (blockIdx.x == 0) { unsigned* z = (unsigned*)(p_karg.ws + WS_BAR); for (int i = (int)threadIdx.x; i < XCD_BAR_WORDS + 64 * 64; i += 512) z[i] = 0u; }
    XcdBarrier bar; bar.bar = (unsigned*)(p_karg.ws + WS_BAR); bar.x = xb_xcc_id(); bar.st = (volatile LAS unsigned*)(lds + LDS_BARST);
    int xrank = 0;
    int vblk = (int)blockIdx.x;
    for (int ph = 0; ph < NPHASE; ++ph) {
        int id = ph == 0 ? 0 : (ph == NPHASE - 1 ? 15 : 1 + (ph - 1) % 14), l = ph == 0 ? 0 : (ph == NPHASE - 1 ? 0 : (ph - 1) / 14);
        asm volatile("" : "+s"(id), "+s"(l));
        const __attribute__((address_space(4))) Params* kp = (const __attribute__((address_space(4))) Params*)__builtin_amdgcn_kernarg_segment_ptr();
        asm volatile("" : "+s"(kp));
        const Params& p = *(const Params*)kp;
      for (int rep = 0; rep < 2; ++rep) {
        unsigned char* ws = p.ws;
        bf16_t* H = (bf16_t*)(ws + WS_H); bf16_t* ACT = (bf16_t*)(ws + WS_PA); bf16_t* PA = (bf16_t*)(ws + WS_PA); bf16_t* PG = (bf16_t*)(ws + WS_PG);
        bf16_t* MG = (bf16_t*)(ws + WS_PA); bf16_t* P = (bf16_t*)(ws + WS_P); bf16_t* GO = (bf16_t*)(ws + WS_H);
        float* xc = (float*)(ws + WS_CX); float* SP = (float*)(ws + WS_SP); float* SQ = (float*)(ws + WS_SQ) + (size_t)l * 3 * RL; const float* BIASL = (const float*)(ws + WS_BIAS) + (size_t)l * BIAS_L; const float* MOD = (const float*)(ws + WS_MOD);
        const unsigned char* wl = ws + WS_W + (size_t)l * WL_SIZE; const float* modl = MOD + (size_t)l * 3 * NMOD;
        const bool lastl = (l == DEPTH - 1); const bool fastfinal = ((int)gridDim.x == 256);
        switch (id) {
            case 0: phase0(p, lds); break;
            case 1: norm_phase(p, l, 0, l > 0 ? 11 : 0, R, l == 0 ? p.x : p.out, l == 0 ? p.ctx : xc, (FUSE_A && l > 0) ? 1 : 0); if (l == 0) bias_phase(p); break;
            case 2: run_gemm(lds, vblk, H, (const bf16_t*)(wl + WL_UP1), 2 * DFF, D, 1, EpiSwiGLU{ACT, (FUSE_A && l > 0) ? SQ : nullptr, BIASL + B_UP1}); break;
            case 3: run_gemm(lds, vblk, ACT, (const bf16_t*)(wl + WL_DN1), D, DFF, 11, EpiResid{p.out, l == 0 ? p.x : p.out, modl + 2 * D, SP, FUSE_B ? H : nullptr, p.norm_w + (size_t)(l * 3 + 1) * D, modl + 4 * D, SQ + RL, 0.5f}); break;
            case 4: norm_phase(p, l, 1, 11, R, p.out, l == 0 ? p.ctx : xc, FUSE_B); break;
            case 5: run_gemm(lds, vblk, H, (const bf16_t*)(wl + WL_WIN), 4096, D, 1, EpiProj{PA, PG, FUSE_B ? SQ + RL : nullptr, BIASL + B_WIN}); lowrank_phase(p, l, vblk, FUSE_B ? SQ + RL : nullptr, BIASL + B_LR); break;
            case 6: gla_kv_phase(p, l, lds); break;
            case 7: gla_scan_phase(p); break;
            case 8: gla_out_phase(p, l, lds, l == DEPTH - 1 ? NGI - 32 : NGI); break;
            case 9: run_gemm(lds, vblk, P, (const bf16_t*)(wl + WL_WPT), D, 512, 0, EpiBranch{MG, PG, 0, 0}); break;
            case 10: run_gemm(lds, vblk, GO, (const bf16_t*)(wl + WL_WGT), D, 512, 0, EpiBranch{MG, PG, 1024, 1}); if (!lastl) ctx_branch_direct(p, l); break;
            case 11: run_gemm(lds, vblk, MG, (const bf16_t*)(wl + WL_WOT), D, D, lastl ? 0 : 4, EpiResid{p.out, p.out, modl + 5 * D, SP, FUSE_A ? H : nullptr, p.norm_w + (size_t)(l * 3 + 2) * D, modl + 7 * D, SQ + 2 * RL, 1.0f}); break;
            case 12: norm_phase(p, l, 2, 4, lastl ? RL : R, p.out, xc, FUSE_A); break;
            case 13: run_gemm(lds, vblk, H, (const bf16_t*)(wl + WL_UP2), 2 * DFF, D, lastl ? 0 : 1, EpiSwiGLU{ACT, FUSE_A ? SQ + 2 * RL : nullptr, BIASL + B_UP2}); break;
            case 14: if (lastl && fastfinal) run_gemm(lds, vblk, ACT, (const bf16_t*)(wl + WL_DN2), D, DFF, 0, EpiFinal{p.out, p.out, modl + 8 * D, p.final_norm_w, (float*)(ws + WS_XCH), (unsigned*)(ws + WS_FCNT), 0.5f});
                else run_gemm(lds, vblk, ACT, (const bf16_t*)(wl + WL_DN2), D, DFF, lastl ? 0 : 11, EpiResid{p.out, p.out, modl + 8 * D, SP, (FUSE_A && !lastl) ? H : nullptr, p.norm_w + (size_t)((l + 1) * 3) * D, modl + 3 * NMOD + D, SQ + 3 * RL, 0.5f}); break;
            default: if (!fastfinal) final_norm(p); break;
        }
        if (!((PROBE_MASK >> id) & 1)) break;
      }
        if (ph == 0) {
            grid.sync();
            if (threadIdx.x == 0) ((volatile LAS unsigned*)(lds + LDS_BARST))[2] = xb_add(&bar.bar[XB_XCNT(bar.x)], 1u);
            __syncthreads();
            xrank = __builtin_amdgcn_readfirstlane((int)((volatile LAS unsigned*)(lds + LDS_BARST))[2]);
        } else if (ph != NPHASE - 1 && id != 9 && !(FUSE_A && id == 12 && l == DEPTH - 1) && !((int)gridDim.x == 256 && id == 14 && l == DEPTH - 1)) xcd_barrier(bar);
        if (ph == 1) {
            bool ok = (gridDim.x == 256);
#pragma unroll
            for (unsigned j = 0; j < 16; ++j) { const unsigned cnt = xb_ld(&bar.bar[XB_XCNT(j)]); ok = ok && (cnt == (j < 8 ? 32u : 0u)); }
            vblk = ok ? xrank * 8 + (int)bar.x : (int)blockIdx.x;
            vblk = __builtin_amdgcn_readfirstlane(vblk);
        }
    }
}

extern "C" void kernel_launch(void* const* d_in, const int* in_sizes, int n_in, void* d_out, int out_size, void* d_ws, size_t ws_size, hipStream_t stream) {
    static int grid_blocks = 0;
    if (grid_blocks == 0) {
        if (n_in != 23 || out_size != RL * D || ws_size < WS_TOTAL) { fprintf(stderr, "kernel_launch: unexpected sizes (n_in %d out %d ws %zu need %zu)\n", n_in, out_size, ws_size, (size_t)WS_TOTAL); grid_blocks = -1; return; }
        int dev = 0, cus = 0, per_cu = 0;
        if (hipGetDevice(&dev) != hipSuccess || hipDeviceGetAttribute(&cus, hipDeviceAttributeMultiprocessorCount, dev) != hipSuccess) { grid_blocks = -1; return; }
        if (hipFuncSetAttribute((const void*)fwd_megakernel, hipFuncAttributeMaxDynamicSharedMemorySize, LDS_BYTES) != hipSuccess) { fprintf(stderr, "kernel_launch: hipFuncSetAttribute failed\n"); grid_blocks = -1; return; }
        if (hipOccupancyMaxActiveBlocksPerMultiprocessor(&per_cu, (const void*)fwd_megakernel, 512, LDS_BYTES) != hipSuccess || per_cu < 1) { fprintf(stderr, "kernel_launch: occupancy query failed (%d)\n", per_cu); grid_blocks = -1; return; }
        grid_blocks = cus * per_cu;
    }
    if (grid_blocks < 0) return;
    Params p{};
    const float** pp = (const float**)&p;
    for (int i = 0; i < 23; ++i) pp[i] = (const float*)d_in[i];
    p.out = (float*)d_out; p.ws = (unsigned char*)d_ws;
    void* args[] = {&p};
    hipError_t e = hipLaunchCooperativeKernel((const void*)fwd_megakernel, dim3(grid_blocks), dim3(512), args, LDS_BYTES, stream);
    if (e != hipSuccess) fprintf(stderr, "cooperative launch failed: %s (grid %d)\n", hipGetErrorString(e), grid_blocks);
}
```
